# Optimizing an MI355X kernel written in HIP

```python
import jax, jax.numpy as jnp
from jax import lax
import numpy as np

D_MODEL = 1024
BATCH = 8
SEQ = 2048
DEPTH = 1

GRID_W = 64
CTX_LEN = 256
D_MIX = D_MODEL
D_ATTN = D_MIX // 2
D_CONV = D_MIX - D_ATTN
HEAD_DIM = 64
N_HEADS = D_ATTN // HEAD_DIM
WIN_H = 8
WIN_W = 16
CONV_K = 3
ROPE_THETA = 10000.0
RMS_EPS = 1e-6
SPLIT_POINTS = (D_ATTN, 2 * D_ATTN, 3 * D_ATTN, 4 * D_ATTN,
                4 * D_ATTN + D_CONV, 4 * D_ATTN + 2 * D_CONV, 4 * D_ATTN + 3 * D_CONV)
D_IN = 4 * D_ATTN + 4 * D_CONV

kernel_name = "hybrid_natten_shortconv_dit_block"


def rmsnorm(x, g):
    xf = x.astype(jnp.float32)
    y = xf * lax.rsqrt(jnp.mean(xf * xf, axis=-1, keepdims=True) + RMS_EPS)
    return (y * g.astype(jnp.float32)).astype(x.dtype)


def adaln(cond, w_ada, b_ada):
    m = jax.nn.silu(cond) @ w_ada + b_ada
    return jnp.split(m, 3, axis=-1)


def heads(t):
    return t.reshape(*t.shape[:-1], N_HEADS, HEAD_DIM)


def axial_rope(t, n_cols):
    S = t.shape[1]
    nf = HEAD_DIM // 4
    inv = ROPE_THETA ** (-jnp.arange(nf, dtype=jnp.float32) / nf)
    pos = jnp.arange(S, dtype=jnp.int32)
    row = (pos // n_cols).astype(jnp.float32)
    col = (pos % n_cols).astype(jnp.float32)
    ang = jnp.stack([row[:, None] * inv, col[:, None] * inv], axis=1)
    cos = jnp.cos(ang)[:, None, :, None, :]
    sin = jnp.sin(ang)[:, None, :, None, :]
    tf = t.astype(jnp.float32).reshape(*t.shape[:-1], 2, 2, nf)
    rot = jnp.stack([-tf[..., 1, :], tf[..., 0, :]], axis=-2)
    return (tf * cos + rot * sin).reshape(t.shape).astype(t.dtype)


def neighbourhood_attention(q, k, v, kc, vc, rpb):
    Bn, S, H, Dh = q.shape
    rows = S // GRID_W
    wh = min(WIN_H, rows)
    scale = Dh ** -0.5
    q_plain = q.reshape(Bn, rows, GRID_W, H, Dh)
    q_rot = axial_rope(q, GRID_W).reshape(Bn, rows, GRID_W, H, Dh)
    k_rot = axial_rope(k, GRID_W).reshape(Bn, rows, GRID_W, H, Dh)
    v_g = v.reshape(Bn, rows, GRID_W, H, Dh)
    qi = jnp.arange(rows)
    row_start = jnp.clip(qi - wh // 2, 0, rows - wh)
    row_idx = row_start[:, None] + jnp.arange(wh)[None, :]
    k_rows = k_rot[:, row_idx]
    v_rows = v_g[:, row_idx]
    cols = jnp.arange(GRID_W)
    col_start = jnp.clip(cols - WIN_W // 2, 0, GRID_W - WIN_W)
    col_valid = (cols[None, :] >= col_start[:, None]) & (cols[None, :] < col_start[:, None] + WIN_W)
    dr = row_idx - qi[:, None] + (WIN_H - 1)
    dc = jnp.clip(cols[None, :] - cols[:, None] + (WIN_W - 1), 0, 2 * WIN_W - 2)
    bias = rpb[:, dr[:, None, :, None], dc[None, :, None, :]].astype(jnp.float32)
    s_lat = jnp.einsum('biqhd,birkhd->bhiqrk', q_rot, k_rows,
                       preferred_element_type=jnp.float32) * scale + bias
    s_lat = jnp.where(col_valid[:, None, :], s_lat, -jnp.inf)
    s_ctx = jnp.einsum('biqhd,blhd->bhiql', q_plain, kc,
                       preferred_element_type=jnp.float32) * scale
    n_lat = wh * GRID_W
    s = jnp.concatenate([s_lat.reshape(*s_lat.shape[:4], n_lat), s_ctx], axis=-1)
    p = jax.nn.softmax(s, axis=-1).astype(v.dtype)
    p_lat = p[..., :n_lat].reshape(s_lat.shape)
    p_ctx = p[..., n_lat:]
    o = (jnp.einsum('bhiqrk,birkhd->biqhd', p_lat, v_rows)
         + jnp.einsum('bhiql,blhd->biqhd', p_ctx, vc))
    return o.reshape(Bn, S, H * Dh)


def context_attention(qc, kc, vc):
    Bn, L, H, Dh = qc.shape
    s = jnp.einsum('blhd,bmhd->bhlm', qc, kc, preferred_element_type=jnp.float32) * (Dh ** -0.5)
    p = jax.nn.softmax(s, axis=-1).astype(vc.dtype)
    return jnp.einsum('bhlm,bmhd->blhd', p, vc).reshape(Bn, L, H * Dh)


def centred_short_conv(u, w, b):
    L = u.shape[1]
    pad = CONV_K // 2
    up = jnp.pad(u, ((0, 0), (pad, pad), (0, 0)))
    y = b
    for i in range(CONV_K):
        y = y + up[:, i:i + L] * w[i]
    return y


def gated_short_conv(u, bg, cg, zc, conv_w, conv_b):
    return bg * centred_short_conv(cg * u, conv_w, conv_b) * jax.nn.silu(zc)


def hybrid_layer(x, ctx, c, c_ctx, w_ada, b_ada, norm_g, w_in, q_norm_g, k_norm_g,
                 rpb, conv_w, conv_b, w_out, update_ctx):
    shift, scale, gate = adaln(c, w_ada, b_ada)
    shift_c, scale_c, gate_c = adaln(c_ctx, w_ada, b_ada)
    h = rmsnorm(x, norm_g) * (1 + scale[:, None]) + shift[:, None]
    hc = rmsnorm(ctx, norm_g) * (1 + scale_c) + shift_c
    q, k, v, za, u, bg, cg, zc = jnp.split(h @ w_in, SPLIT_POINTS, axis=-1)
    q = rmsnorm(heads(q), q_norm_g)
    k = rmsnorm(heads(k), k_norm_g)
    if update_ctx:
        qc, kc, vc, zac, uc, bgc, cgc, zcc = jnp.split(hc @ w_in, SPLIT_POINTS, axis=-1)
    else:
        kc, vc = jnp.split(hc @ w_in[:, D_ATTN:3 * D_ATTN], 2, axis=-1)
    kc = rmsnorm(heads(kc), k_norm_g)
    vc = heads(vc)
    attn = neighbourhood_attention(q, k, heads(v), kc, vc, rpb) * jax.nn.silu(za)
    conv = gated_short_conv(u, bg, cg, zc, conv_w, conv_b)
    x_new = x + gate[:, None] * (jnp.concatenate([attn, conv], axis=-1) @ w_out)
    if update_ctx:
        qc = rmsnorm(heads(qc), q_norm_g)
        attn_c = context_attention(qc, kc, vc) * jax.nn.silu(zac)
        conv_c = gated_short_conv(uc, bgc, cgc, zcc, conv_w, conv_b)
        ctx_new = ctx + gate_c * (jnp.concatenate([attn_c, conv_c], axis=-1) @ w_out)
    else:
        ctx_new = ctx
    return x_new, ctx_new


def setup_inputs(seed: int = 0) -> dict:
    key = jax.random.key(seed)
    ks = jax.random.split(key, 14)
    f32 = jnp.float32
    x = jax.random.normal(ks[0], (BATCH, SEQ, D_MODEL), f32)
    c = jax.random.normal(ks[1], (BATCH, D_MODEL), f32)
    ctx = jax.random.normal(ks[2], (BATCH, CTX_LEN, D_MODEL), f32)
    c_ctx = jax.random.normal(ks[3], (D_MODEL,), f32)
    w_ada = jax.random.normal(ks[4], (DEPTH, D_MODEL, 3 * D_MODEL), f32) * (0.5 * D_MODEL ** -0.5)
    b_ada = jax.random.normal(ks[5], (DEPTH, 3 * D_MODEL), f32) * 0.01
    norm_g = 1.0 + 0.1 * jax.random.normal(ks[6], (DEPTH, D_MODEL), f32)
    w_in = jax.random.normal(ks[7], (DEPTH, D_MODEL, D_IN), f32) * D_MODEL ** -0.5
    q_norm_g = 1.0 + 0.1 * jax.random.normal(ks[8], (DEPTH, HEAD_DIM), f32)
    k_norm_g = 1.0 + 0.1 * jax.random.normal(ks[9], (DEPTH, HEAD_DIM), f32)
    rpb = 0.1 * jax.random.normal(ks[10], (DEPTH, N_HEADS, 2 * WIN_H - 1, 2 * WIN_W - 1), f32)
    conv_w = jax.random.normal(ks[11], (DEPTH, CONV_K, D_CONV), f32) * CONV_K ** -0.5
    conv_b = 0.01 * jax.random.normal(ks[12], (DEPTH, D_CONV), f32)
    w_out = jax.random.normal(ks[13], (DEPTH, D_MIX, D_MODEL), f32) * D_MIX ** -0.5
    return {"x": x, "c": c, "ctx": ctx, "c_ctx": c_ctx, "w_ada": w_ada, "b_ada": b_ada,
            "norm_g": norm_g, "w_in": w_in, "q_norm_g": q_norm_g, "k_norm_g": k_norm_g,
            "rpb": rpb, "conv_w": conv_w, "conv_b": conv_b, "w_out": w_out}


def reference(x, c, ctx, c_ctx, w_ada, b_ada, norm_g, w_in, q_norm_g, k_norm_g,
              rpb, conv_w, conv_b, w_out):
    for l in range(DEPTH):
        x, ctx = hybrid_layer(x, ctx, c, c_ctx, w_ada[l], b_ada[l], norm_g[l], w_in[l],
                              q_norm_g[l], k_norm_g[l], rpb[l], conv_w[l], conv_b[l], w_out[l],
                              update_ctx=(l < DEPTH - 1))
    return x
```

```cpp
#include <hip/hip_runtime.h>
#include <hip/hip_cooperative_groups.h>
#include <cstdio>
#include <cstdint>
namespace cg = cooperative_groups;

#ifndef N_LAUNCH_MODE
#define N_LAUNCH_MODE 5
#endif

#define LAS __attribute__((address_space(3)))
typedef unsigned short bf16_t;
typedef short bf16x8 __attribute__((ext_vector_type(8)));
typedef float f32x4 __attribute__((ext_vector_type(4)));
typedef float f32x2 __attribute__((ext_vector_type(2)));
typedef unsigned u32x4 __attribute__((ext_vector_type(4)));
typedef unsigned u32x2 __attribute__((ext_vector_type(2)));
typedef __bf16 bf16x2_t __attribute__((ext_vector_type(2)));

constexpr int NBATCH = 8, SEQ = 2048, DM = 1024, CTXL = 256, NH = 8, HD = 64;
constexpr int MLAT = NBATCH * SEQ, MCTX = NBATCH * CTXL, MTOT = MLAT + MCTX;
constexpr int DIN = 4096, NADA = 3072;
constexpr float RMS_EPS = 1e-6f;
constexpr float LOG2E = 1.4426950408889634f;

constexpr size_t MiB = 1u << 20;
constexpr size_t WS_WT = 0;
constexpr size_t WS_WO = 8 * MiB;
constexpr size_t WS_ADAP = 10 * MiB;
constexpr size_t WS_GATE = 11 * MiB;
constexpr size_t WS_ROPE = 11 * MiB + 65536;
constexpr size_t WS_BND = 11 * MiB + 131072;
constexpr size_t WS_XN = 12 * MiB;
constexpr size_t WS_QP = 48 * MiB;
constexpr size_t WS_QR = 64 * MiB;
constexpr size_t WS_KR = 80 * MiB;
constexpr size_t WS_KC = 96 * MiB;
constexpr size_t WS_VT = 98 * MiB;
constexpr size_t WS_ZA = 116 * MiB;
constexpr size_t WS_CG = 132 * MiB;
constexpr size_t WS_MIX = 164 * MiB;
constexpr size_t WS_END = 196 * MiB;

constexpr int LDS_BYTES = 147456;
constexpr int NTHREADS = 512;

struct Params {
    const float *x, *c, *ctx, *c_ctx, *w_ada, *b_ada, *norm_g, *w_in, *q_norm_g, *k_norm_g, *rpb, *conv_w, *conv_b, *w_out;
    float* out; unsigned char* ws; int ph_lo, ph_hi;
};

__device__ __forceinline__ unsigned cvtpk(float lo, float hi) { f32x2 v = {lo, hi}; bf16x2_t b = __builtin_convertvector(v, bf16x2_t); return __builtin_bit_cast(unsigned, b); }
__device__ __forceinline__ float bf2f(unsigned short h) { return __builtin_bit_cast(float, (unsigned)h << 16); }
__device__ __forceinline__ float silu_f(float v) { return v * __builtin_amdgcn_rcpf(1.0f + __builtin_amdgcn_exp2f(-v * LOG2E)); }
__device__ __forceinline__ float wave_sum(float v) {
#pragma unroll
    for (int o = 1; o < 64; o <<= 1) v += __shfl_xor(v, o);
    return v;
}

constexpr int BM = 256, BK = 64, HALF = 128, HTB = HALF * BK * 2, KDIM = 1024;
constexpr size_t TSTEP = (size_t)BM * KDIM * 2;
__device__ __forceinline__ int lds_byte(int r, int c) { const int st = (r >> 4) * 2 + (c >> 5), rr = r & 15, cc = c & 31, ob = rr * 64 + cc * 2; return st * 1024 + (ob ^ (((ob >> 9) & 1) << 5)); }
__device__ __forceinline__ void stage_rc(int b, int& R, int& C) { const int st = b / 1024, sb = b % 1024, swz = sb ^ (((sb >> 9) & 1) << 5); R = (st >> 1) * 16 + swz / 64; C = (st & 1) * 32 + (swz % 64) / 2; }
__device__ __forceinline__ int perm32(int rho) { const int n = rho >> 4, i = rho & 15; return 8 * (i >> 2) + 4 * n + (i & 3); }

struct Unit { const char* a; const char* b; int kind, pm, pn; };

struct EpiCtx {
    bf16_t *QP, *QR, *KR, *KC, *VT, *ZA, *CG;
    const float *gq, *gk, *rope;
    const float *x, *gate; float* out;
};

template <int PH>
__device__ __forceinline__ void epilogue(const f32x4 (&acc)[2][2][4][2], const Unit& u, int wr, int wc, int fr, int fq, const EpiCtx& E) {
    if constexpr (PH == 4) {
        const int b = (u.pm * BM) >> 11;
        const int c0 = u.pn * BM + wc * 32 + fq * 8;
        f32x4 gv[2][2];
#pragma unroll
        for (int bj = 0; bj < 2; ++bj)
#pragma unroll
            for (int n = 0; n < 2; ++n) gv[bj][n] = *(const f32x4*)(E.gate + b * DM + c0 + bj * HALF + 4 * n);
#pragma unroll
        for (int ai = 0; ai < 2; ++ai)
#pragma unroll
            for (int m = 0; m < 4; ++m) {
                const size_t off = (size_t)(u.pm * BM + ai * HALF + wr * 64 + m * 16 + fr) * DM + c0;
#pragma unroll
                for (int bj = 0; bj < 2; ++bj)
#pragma unroll
                    for (int n = 0; n < 2; ++n) {
                        const f32x4 xv = *(const f32x4*)(E.x + off + bj * HALF + 4 * n);
                        *(f32x4*)(E.out + off + bj * HALF + 4 * n) = xv + gv[bj][n] * acc[ai][bj][m][n];
                    }
            }
    } else {
        const int kind = u.kind;
        if (kind == 0 || kind == 1 || kind == 5) {
            const bool isq = (kind == 0);
            const float* g = isq ? E.gq : E.gk;
            const float qs = isq ? 0.125f * LOG2E : 1.0f;
            const int head = 4 * (u.pn & 1) + wc;
            f32x4 gv[2][2];
#pragma unroll
            for (int bj = 0; bj < 2; ++bj)
#pragma unroll
                for (int n = 0; n < 2; ++n) gv[bj][n] = *(const f32x4*)(g + 32 * bj + 16 * n + 4 * fq);
#pragma unroll
            for (int ai = 0; ai < 2; ++ai)
#pragma unroll
                for (int m = 0; m < 4; ++m) {
                    const int r = u.pm * BM + ai * HALF + wr * 64 + m * 16 + fr;
                    f32x4 v[2][2]; float ss = 0.f;
#pragma unroll
                    for (int bj = 0; bj < 2; ++bj)
#pragma unroll
                        for (int n = 0; n < 2; ++n) { v[bj][n] = acc[ai][bj][m][n]; const f32x4 t = v[bj][n] * v[bj][n]; ss += (t[0] + t[1]) + (t[2] + t[3]); }
                    ss += __shfl_xor(ss, 16); ss += __shfl_xor(ss, 32);
                    const float rinv = __builtin_amdgcn_rsqf(ss * (1.0f / 64.0f) + RMS_EPS) * qs;
#pragma unroll
                    for (int bj = 0; bj < 2; ++bj)
#pragma unroll
                        for (int n = 0; n < 2; ++n) v[bj][n] = v[bj][n] * rinv * gv[bj][n];
                    if (kind == 5) {
                        const int rc = r - MLAT, b = rc >> 8, l = rc & 255;
                        bf16_t* dst = E.KC + ((size_t)((b * NH + head) * CTXL + l)) * HD + fq * 16;
#pragma unroll
                        for (int bj = 0; bj < 2; ++bj) { u32x4 w; w.x = cvtpk(v[bj][0][0], v[bj][0][1]); w.y = cvtpk(v[bj][0][2], v[bj][0][3]); w.z = cvtpk(v[bj][1][0], v[bj][1][1]); w.w = cvtpk(v[bj][1][2], v[bj][1][3]); *(u32x4*)(dst + bj * 8) = w; }
                    } else {
                        const int b = r >> 11, t = r & 2047, grow = t >> 6, gcol = t & 63;
                        const size_t rowoff = ((size_t)((b * NH + head) * SEQ + t)) * HD + fq * 16;
                        if (isq) {
                            bf16_t* dst = E.QP + rowoff;
#pragma unroll
                            for (int bj = 0; bj < 2; ++bj) { u32x4 w; w.x = cvtpk(v[bj][0][0], v[bj][0][1]); w.y = cvtpk(v[bj][0][2], v[bj][0][3]); w.z = cvtpk(v[bj][1][0], v[bj][1][1]); w.w = cvtpk(v[bj][1][2], v[bj][1][3]); *(u32x4*)(dst + bj * 8) = w; }
                        }
                        bf16_t* dst = (isq ? E.QR : E.KR) + rowoff;
#pragma unroll
                        for (int bj = 0; bj < 2; ++bj) {
                            const int pos = bj ? gcol : grow;
                            const f32x4 cs = *(const f32x4*)(E.rope + pos * 16 + 4 * fq), sn = *(const f32x4*)(E.rope + 1024 + pos * 16 + 4 * fq);
                            const f32x4 o0 = v[bj][0] * cs - v[bj][1] * sn, o1 = v[bj][1] * cs + v[bj][0] * sn;
                            u32x4 w; w.x = cvtpk(o0[0], o0[1]); w.y = cvtpk(o0[2], o0[3]); w.z = cvtpk(o1[0], o1[1]); w.w = cvtpk(o1[2], o1[3]);
                            *(u32x4*)(dst + bj * 8) = w;
                        }
                    }
                }
        } else if (kind == 2) {
            const int c0 = (u.pn - 6) * BM + wc * 32 + fq * 8;
#pragma unroll
            for (int ai = 0; ai < 2; ++ai)
#pragma unroll
                for (int m = 0; m < 4; ++m) {
                    bf16_t* dst = E.ZA + (size_t)(u.pm * BM + ai * HALF + wr * 64 + m * 16 + fr) * 512 + c0;
#pragma unroll
                    for (int bj = 0; bj < 2; ++bj) {
                        const f32x4 a0 = acc[ai][bj][m][0], a1 = acc[ai][bj][m][1];
                        u32x4 w; w.x = cvtpk(silu_f(a0[0]), silu_f(a0[1])); w.y = cvtpk(silu_f(a0[2]), silu_f(a0[3])); w.z = cvtpk(silu_f(a1[0]), silu_f(a1[1])); w.w = cvtpk(silu_f(a1[2]), silu_f(a1[3]));
                        *(u32x4*)(dst + bj * HALF) = w;
                    }
                }
        } else if (kind == 3) {
            const int ch0 = (u.pn - 8) * 64 + wc * 16 + fq * 4;
#pragma unroll
            for (int ai = 0; ai < 2; ++ai)
#pragma unroll
                for (int m = 0; m < 4; ++m) {
                    const f32x4 uu = acc[ai][0][m][0], bg = acc[ai][0][m][1], cgv = acc[ai][1][m][0], zc = acc[ai][1][m][1];
                    const f32x4 cu = cgv * uu;
                    f32x4 gz;
#pragma unroll
                    for (int j = 0; j < 4; ++j) gz[j] = bg[j] * silu_f(zc[j]);
                    u32x4 w; w.x = cvtpk(cu[0], cu[1]); w.y = cvtpk(cu[2], cu[3]); w.z = cvtpk(gz[0], gz[1]); w.w = cvtpk(gz[2], gz[3]);
                    *(u32x4*)(E.CG + (size_t)(u.pm * BM + ai * HALF + wr * 64 + m * 16 + fr) * 1024 + ch0 * 2) = w;
                }
        } else {
            const int c0 = u.pn * BM + wc * 32 + fq * 8;
#pragma unroll
            for (int ai = 0; ai < 2; ++ai)
#pragma unroll
                for (int m = 0; m < 4; ++m) {
                    bf16_t* dst = E.VT + (size_t)(u.pm * BM + ai * HALF + wr * 64 + m * 16 + fr) * MTOT + c0;
#pragma unroll
                    for (int bj = 0; bj < 2; ++bj) {
                        const f32x4 a0 = acc[ai][bj][m][0], a1 = acc[ai][bj][m][1];
                        u32x4 w; w.x = cvtpk(a0[0], a0[1]); w.y = cvtpk(a0[2], a0[3]); w.z = cvtpk(a1[0], a1[1]); w.w = cvtpk(a1[2], a1[3]);
                        *(u32x4*)(dst + bj * HALF) = w;
                    }
                }
        }
    }
}

struct SchedP2 {
    int x, lb, nb; const char* XN; const char* WT;
    __device__ __forceinline__ bool next(int i, Unit& u) const {
        const int uu = lb + i * nb; if (uu >= 132) return false;
        if (uu < 112) {
            const int pi = uu >> 3, pm = 8 * x + (uu & 7), pn = pi < 4 ? pi : pi + 2;
            u.kind = pn < 2 ? 0 : (pn < 4 ? 1 : (pn < 8 ? 2 : 3)); u.pm = pm; u.pn = pn; u.a = XN + (size_t)pm * TSTEP; u.b = WT + (size_t)pn * TSTEP;
        } else if (uu < 130) {
            const int v = uu - 112, pnp = 9 * x + v % 9, pmp = v / 9;
            u.kind = 4; u.pm = pmp; u.pn = pnp; u.a = WT + (size_t)(4 + pmp) * TSTEP; u.b = XN + (size_t)pnp * TSTEP;
        } else {
            u.kind = 5; u.pm = 64 + x; u.pn = 2 + (uu - 130); u.a = XN + (size_t)u.pm * TSTEP; u.b = WT + (size_t)u.pn * TSTEP;
        }
        return true;
    }
};
struct SchedP4 {
    int x, lb, nb; const char* MIX; const char* WO;
    __device__ __forceinline__ bool next(int i, Unit& u) const {
        const int uu = lb + i * nb; if (uu >= 32) return false;
        u.kind = 6; u.pm = 8 * x + (uu & 7); u.pn = uu >> 3; u.a = MIX + (size_t)u.pm * TSTEP; u.b = WO + (size_t)u.pn * TSTEP; return true;
    }
};

template <int PH, class Sched>
__device__ __forceinline__ void gemm_phase(LAS unsigned char* lds, const Sched& S, const EpiCtx& E) {
    const int tid = threadIdx.x, wid = __builtin_amdgcn_readfirstlane(tid >> 6), lane = tid & 63, wr = wid >> 2, wc = wid & 3, fr = lane & 15, fq = lane >> 4;
    constexpr int K = KDIM, nt = K / BK;
    unsigned voffA[2], voffB[2];
#pragma unroll
    for (int i = 0; i < 2; ++i) { int R, C; stage_rc(tid * 16 + i * 8192, R, C); const int Rb = (R & ~31) + perm32(R & 31);
        voffA[i] = (unsigned)(R * K + C) * 2u; voffB[i] = (unsigned)(Rb * K + C) * 2u; }
    const size_t kstep = (size_t)(BK * 2);
    const size_t hstep = (size_t)HALF * K * 2;
    const unsigned ldsw = (unsigned)wid * 1024u;
    const int aoff = lds_byte(wr * 64 + fr, fq * 8), boff = lds_byte(wc * 32 + fr, fq * 8);
#define PG8_SA(b, h) (((b) * 2 + (h)) * HTB)
#define PG8_SB(b, h) ((4 + (b) * 2 + (h)) * HTB)
#define PG8_STAGE(bufoff, gbase, voff) do { _Pragma("unroll") for (int _i = 0; _i < 2; ++_i) \
        __builtin_amdgcn_global_load_lds((const unsigned*)((const char*)(gbase) + (voff)[_i]), (LAS unsigned*)(lds + (bufoff) + ldsw + _i * 8192), 16, 0, 0); } while (0)
#define PG8_LDA(dst, b, h) do { _Pragma("unroll") for (int m = 0; m < 4; ++m) _Pragma("unroll") for (int k = 0; k < 2; ++k) dst[m][k] = *(const LAS bf16x8*)(lds + PG8_SA(b, h) + aoff + m * 2048 + k * 1024); } while (0)
#define PG8_LDB(dst, b, h) do { _Pragma("unroll") for (int n = 0; n < 2; ++n) _Pragma("unroll") for (int k = 0; k < 2; ++k) dst[n][k] = *(const LAS bf16x8*)(lds + PG8_SB(b, h) + boff + n * 2048 + k * 1024); } while (0)
#define PG8_MMA(ai, bj, At, Bt) do { __builtin_amdgcn_s_setprio(1); _Pragma("unroll") for (int m = 0; m < 4; ++m) _Pragma("unroll") for (int n = 0; n < 2; ++n) _Pragma("unroll") for (int k = 0; k < 2; ++k) \
        acc[ai][bj][m][n] = __builtin_amdgcn_mfma_f32_16x16x32_bf16(Bt[n][k], At[m][k], acc[ai][bj][m][n], 0, 0, 0); __builtin_amdgcn_s_setprio(0); } while (0)
#define PG8_WAIT_V(n) asm volatile("s_waitcnt vmcnt(" #n ")" ::: "memory")
#define PG8_WAIT_L(n) asm volatile("s_waitcnt lgkmcnt(" #n ")" ::: "memory")
#define PG8_BAR __builtin_amdgcn_s_barrier()
#define PG8_SCHED __builtin_amdgcn_sched_barrier(0)
    Unit cur, nxt; int ui = 0;
    if (!S.next(0, cur)) return;
    f32x4 acc[2][2][4][2];
#pragma unroll
    for (int a = 0; a < 2; ++a)
#pragma unroll
        for (int b = 0; b < 2; ++b)
#pragma unroll
            for (int m = 0; m < 4; ++m)
#pragma unroll
                for (int n = 0; n < 2; ++n) acc[a][b][m][n] = (f32x4){0.f, 0.f, 0.f, 0.f};
    bf16x8 At[4][2], B0[2][2], B1[2][2];
    const char* cA = cur.a; const char* cB = cur.b;
    PG8_STAGE(PG8_SB(0, 0), cB, voffB); PG8_STAGE(PG8_SB(0, 1), cB + hstep, voffB); PG8_STAGE(PG8_SA(0, 0), cA, voffA); PG8_STAGE(PG8_SA(0, 1), cA + hstep, voffA);
    if (wr == 1) PG8_BAR;
    PG8_WAIT_V(2); PG8_BAR;
    PG8_STAGE(PG8_SB(1, 0), cB + kstep, voffB); PG8_STAGE(PG8_SA(1, 0), cA + kstep, voffA); PG8_STAGE(PG8_SB(1, 1), cB + hstep + kstep, voffB);
    PG8_WAIT_V(6); PG8_BAR;
    for (;;) {
        const bool has_next = S.next(ui + 1, nxt);
        const char* nA = has_next ? nxt.a : cA; const char* nB = has_next ? nxt.b : cB;
        for (int t = 0; t < nt; t += 2) {
            const bool last = (t == nt - 2);
            const char* a1 = cA + (size_t)(t + 1) * kstep;
            const char* a2 = last ? nA : cA + (size_t)(t + 2) * kstep; const char* b2 = last ? nB : cB + (size_t)(t + 2) * kstep;
            const char* a3 = a2 + kstep; const char* b3 = b2 + kstep;
            PG8_LDB(B0, 0, 0); PG8_LDB(B1, 0, 1); PG8_SCHED; PG8_LDA(At, 0, 0); PG8_STAGE(PG8_SA(1, 1), a1 + hstep, voffA);
            PG8_WAIT_V(8); PG8_WAIT_L(0); PG8_BAR; PG8_MMA(0, 0, At, B0); PG8_MMA(0, 1, At, B1); PG8_BAR; PG8_SCHED;
            PG8_LDA(At, 0, 1); PG8_STAGE(PG8_SB(0, 0), b2, voffB); PG8_STAGE(PG8_SB(0, 1), b2 + hstep, voffB); PG8_STAGE(PG8_SA(0, 0), a2, voffA);
            PG8_WAIT_V(8); PG8_WAIT_L(0); PG8_BAR; PG8_MMA(1, 0, At, B0); PG8_MMA(1, 1, At, B1); PG8_BAR; PG8_SCHED;
            PG8_LDB(B0, 1, 0); PG8_LDB(B1, 1, 1); PG8_SCHED; PG8_LDA(At, 1, 0); PG8_STAGE(PG8_SA(0, 1), a2 + hstep, voffA);
            PG8_WAIT_V(8); PG8_WAIT_L(0); PG8_BAR; PG8_MMA(0, 0, At, B0); PG8_MMA(0, 1, At, B1); PG8_BAR; PG8_SCHED;
            PG8_LDA(At, 1, 1); PG8_STAGE(PG8_SB(1, 0), b3, voffB); PG8_STAGE(PG8_SB(1, 1), b3 + hstep, voffB); PG8_STAGE(PG8_SA(1, 0), a3, voffA);
            PG8_WAIT_V(8); PG8_WAIT_L(0); PG8_BAR; PG8_MMA(1, 0, At, B0); PG8_MMA(1, 1, At, B1); PG8_BAR; PG8_SCHED;
        }
        if (wr == 0) PG8_BAR;
        epilogue<PH>(acc, cur, wr, wc, fr, fq, E);
        if (!has_next) break;
#pragma unroll
        for (int a = 0; a < 2; ++a)
#pragma unroll
            for (int b = 0; b < 2; ++b)
#pragma unroll
                for (int m = 0; m < 4; ++m)
#pragma unroll
                    for (int n = 0; n < 2; ++n) acc[a][b][m][n] = (f32x4){0.f, 0.f, 0.f, 0.f};
        cur = nxt; cA = nA; cB = nB; ++ui;
        if (wr == 1) PG8_BAR;
    }
    PG8_WAIT_V(0);
    PG8_BAR;
#undef PG8_SA
#undef PG8_SB
#undef PG8_STAGE
#undef PG8_LDA
#undef PG8_LDB
#undef PG8_MMA
#undef PG8_WAIT_V
#undef PG8_WAIT_L
#undef PG8_BAR
#undef PG8_SCHED
}

__device__ __forceinline__ int wt_dst_row(int c) {
    if (c < 1024) {
        const int base = c & ~511, local = c & 511, head = local >> 6, d = local & 63;
        const int pnl = head >> 2, wc = head & 3, bj = d >> 5, n = (d >> 4) & 1, f = d & 15, fq = f >> 2, j = f & 3;
        return base + pnl * 256 + 128 * bj + 32 * wc + 8 * fq + 4 * n + j;
    } else if (c < 2048) {
        return c;
    } else {
        const int type = (c - 2048) >> 9, ch = (c - 2048) & 511, ct = ch >> 6, chl = ch & 63;
        const int wc = chl >> 4, fq = (chl >> 2) & 3, j = chl & 3, bj = type >> 1, n = type & 1;
        return 2048 + ct * 256 + 128 * bj + 32 * wc + 8 * fq + 4 * n + j;
    }
}
template <bool PERMUTE>
__device__ __forceinline__ void p0_transpose_item(const float* W, int N, bf16_t* WT, LAS float* scr, int item, int lane) {
    const int nblk = N / 32, kb = item / nblk, nb = item % nblk, k0 = 64 * kb, n0 = 32 * nb;
#pragma unroll 8
    for (int i = 0; i < 32; ++i) { const int kk = 2 * i + (lane >> 5); scr[kk * 33 + (lane & 31)] = W[(size_t)(k0 + kk) * N + n0 + (lane & 31)]; }
    asm volatile("s_waitcnt lgkmcnt(0)" ::: "memory");
    const int c = lane & 7;
#pragma unroll
    for (int j = 0; j < 4; ++j) { const int n = (lane >> 3) + 8 * j; const LAS float* s = scr + (8 * c) * 33 + n;
        u32x4 o; o.x = cvtpk(s[0 * 33], s[1 * 33]); o.y = cvtpk(s[2 * 33], s[3 * 33]); o.z = cvtpk(s[4 * 33], s[5 * 33]); o.w = cvtpk(s[6 * 33], s[7 * 33]);
        const int drow = PERMUTE ? wt_dst_row(n0 + n) : (n0 + n);
        *(u32x4*)(WT + (size_t)drow * KDIM + k0 + 8 * c) = o; }
    asm volatile("s_waitcnt lgkmcnt(0)" ::: "memory");
}

__device__ __forceinline__ void phase0(const Params& p, LAS unsigned char* lds) {
    const int tid = threadIdx.x, lane = tid & 63, wave = __builtin_amdgcn_readfirstlane(tid >> 6);
    const int G = gridDim.x;
    LAS float* sc = (LAS float*)lds;
    LAS float* scr = (LAS float*)(lds + 40960 + wave * 8704);
    for (int idx = tid; idx < 9 * 1024; idx += NTHREADS) { const float v = idx < 8192 ? p.c[idx] : p.c_ctx[idx - 8192]; sc[idx] = v * (1.0f / (1.0f + __expf(-v))); }
    __syncthreads();
    bf16_t* WT = (bf16_t*)(p.ws + WS_WT); bf16_t* WO = (bf16_t*)(p.ws + WS_WO);
    float* ADAP = (float*)(p.ws + WS_ADAP);
    const int gw = wave * G + blockIdx.x, NGW = G * 8;
    constexpr int N_ADA = 768, N_TIN = (KDIM / 64) * (DIN / 32), N_TOUT = (KDIM / 64) * (DM / 32);
    for (int it = gw; it < N_ADA + N_TIN + N_TOUT; it += NGW) {
        if (it < N_ADA) {
            const int cgp = it % 96, kc = it / 96, col = cgp * 32 + (lane & 31), k0 = kc * 128 + (lane >> 5) * 64;
            float a[9];
#pragma unroll
            for (int r = 0; r < 9; ++r) a[r] = 0.f;
#pragma unroll 8
            for (int kk = 0; kk < 64; ++kk) {
                const float w = p.w_ada[(size_t)(k0 + kk) * NADA + col];
#pragma unroll
                for (int r = 0; r < 9; ++r) a[r] += sc[r * 1024 + k0 + kk] * w;
            }
#pragma unroll
            for (int r = 0; r < 9; ++r) { a[r] += __shfl_xor(a[r], 32); if (lane < 32) ADAP[(size_t)(kc * 9 + r) * NADA + col] = a[r]; }
        } else if (it < N_ADA + N_TIN) {
            p0_transpose_item<true>(p.w_in, DIN, WT, scr, it - N_ADA, lane);
        } else {
            p0_transpose_item<false>(p.w_out, DM, WO, scr, it - N_ADA - N_TIN, lane);
        }
    }
    if (blockIdx.x == 0) {
        float* rope = (float*)(p.ws + WS_ROPE);
        if (tid < 16) {
            double inv = 1.0; for (int i = 0; i < tid; ++i) inv *= 0.5623413251903491;
            const double a = (double)(float)inv;
            double s = 0.0, c = 0.0, term = 1.0;
            for (int n = 0; n < 24; ++n) { if ((n & 1) == 0) c += ((n & 2) ? -term : term); else s += ((n & 2) ? -term : term); term *= a / (double)(n + 1); }
            double cp = 1.0, sp = 0.0;
            for (int pos = 0; pos < 64; ++pos) { rope[pos * 16 + tid] = (float)cp; rope[1024 + pos * 16 + tid] = (float)sp; const double cn = cp * c - sp * s, sn = sp * c + cp * s; cp = cn; sp = sn; }
        }
        if (wave == 1) {
            float mq = fabsf(p.q_norm_g[lane]), mk = fabsf(p.k_norm_g[lane]), mr = 0.f;
            for (int i = lane; i < NH * 15 * 31; i += 64) mr = fmaxf(mr, fabsf(p.rpb[i]));
#pragma unroll
            for (int o = 1; o < 64; o <<= 1) { mq = fmaxf(mq, __shfl_xor(mq, o)); mk = fmaxf(mk, __shfl_xor(mk, o)); mr = fmaxf(mr, __shfl_xor(mr, o)); }
            if (lane == 0) *(float*)(p.ws + WS_BND) = (8.0f * mq * mk + mr) * LOG2E;
        }
    }
}

__device__ __forceinline__ void phase1(const Params& p, LAS unsigned char* lds) {
    const int tid = threadIdx.x, lane = tid & 63, wave = __builtin_amdgcn_readfirstlane(tid >> 6);
    LAS float* mult = (LAS float*)lds; LAS float* shf = (LAS float*)(lds + 4096);
    const float* ADAP = (const float*)(p.ws + WS_ADAP);
    bf16_t* XN = (bf16_t*)(p.ws + WS_XN); float* GATE = (float*)(p.ws + WS_GATE);
    for (int chunk = blockIdx.x; chunk < 288; chunk += gridDim.x) {
        const bool lat = chunk < 256; const int ci = lat ? (chunk >> 5) : 8;
        __syncthreads();
        for (int k = tid; k < 1024; k += NTHREADS) {
            float sh = p.b_ada[k], scl = p.b_ada[1024 + k];
#pragma unroll
            for (int kc = 0; kc < 8; ++kc) { sh += ADAP[(size_t)(kc * 9 + ci) * NADA + k]; scl += ADAP[(size_t)(kc * 9 + ci) * NADA + 1024 + k]; }
            mult[k] = p.norm_g[k] * (1.0f + scl); shf[k] = sh;
            if (lat && (chunk & 31) == 0) {
                float gt = p.b_ada[2048 + k];
#pragma unroll
                for (int kc = 0; kc < 8; ++kc) gt += ADAP[(size_t)(kc * 9 + ci) * NADA + 2048 + k];
                GATE[ci * DM + k] = gt;
            }
        }
        __syncthreads();
        const float* src = lat ? p.x + (size_t)chunk * 64 * DM : p.ctx + (size_t)(chunk - 256) * 64 * DM;
        bf16_t* dst = XN + (size_t)chunk * 64 * DM;
        for (int rr = wave; rr < 64; rr += 8) {
            const f32x4* xr = (const f32x4*)(src + (size_t)rr * DM) + lane;
            f32x4 v[4]; float s = 0.f;
#pragma unroll
            for (int j = 0; j < 4; ++j) { v[j] = xr[64 * j]; const f32x4 t = v[j] * v[j]; s += (t[0] + t[1]) + (t[2] + t[3]); }
            const float rinv = __builtin_amdgcn_rsqf(wave_sum(s) * (1.0f / DM) + RMS_EPS);
            u32x2* o8 = (u32x2*)(dst + (size_t)rr * DM) + lane;
#pragma unroll
            for (int j = 0; j < 4; ++j) {
                const f32x4 mu = *(const LAS f32x4*)(mult + 4 * lane + 256 * j), sv = *(const LAS f32x4*)(shf + 4 * lane + 256 * j);
                const f32x4 h = v[j] * rinv * mu + sv;
                u32x2 w; w.x = cvtpk(h[0], h[1]); w.y = cvtpk(h[2], h[3]); o8[64 * j] = w;
            }
        }
    }
}

__device__ __forceinline__ void attn_item(const Params& p, const LAS float* btab, float B2, int b, int h, int i, int qc, int lane) {
    const bf16_t* QP = (const bf16_t*)(p.ws + WS_QP); const bf16_t* QR = (const bf16_t*)(p.ws + WS_QR);
    const bf16_t* KR = (const bf16_t*)(p.ws + WS_KR); const bf16_t* KC = (const bf16_t*)(p.ws + WS_KC);
    const bf16_t* VT = (const bf16_t*)(p.ws + WS_VT); const bf16_t* ZA = (const bf16_t*)(p.ws + WS_ZA);
    bf16_t* MIX = (bf16_t*)(p.ws + WS_MIX);
    const int q16 = lane & 15, quad = lane >> 4, bh = b * NH + h;
    const int qcol = qc * 16 + q16;
    const size_t qoff = ((size_t)bh * SEQ + i * 64 + qcol) * HD + quad * 8;
    const bf16x8 qr0 = *(const bf16x8*)(QR + qoff), qr1 = *(const bf16x8*)(QR + qoff + 32);
    const bf16x8 qp0 = *(const bf16x8*)(QP + qoff), qp1 = *(const bf16x8*)(QP + qoff + 32);
    const int rs = min(max(i - 4, 0), 24);
    const int cs = (qc == 0) ? 0 : (qc == 1) ? 8 : (qc == 2) ? 24 : 32;
    const int lo = min(max(qcol - 8, 0), 48);
    const int kcol0 = cs + 8 * quad;
    const int dcb = kcol0 - qcol + 15 + 16;
    unsigned vmask = 0;
#pragma unroll
    for (int j = 0; j < 8; ++j) { const int kc = kcol0 + j; if (kc >= lo && kc < lo + 16) vmask |= (1u << j); }
    const int krow0 = 8 * (q16 >> 2) + (q16 & 3);
    f32x4 o[4];
#pragma unroll
    for (int db = 0; db < 4; ++db) o[db] = (f32x4){0.f, 0.f, 0.f, 0.f};
    float lsum = 0.f;
    const f32x4 zero4 = {0.f, 0.f, 0.f, 0.f};
    const bf16_t* kbase0 = KR + ((size_t)bh * SEQ + rs * 64 + cs + krow0) * HD + quad * 8;
    const bf16_t* vbase0 = VT + (size_t)(h * HD + q16) * MTOT + b * SEQ + rs * 64 + cs + 8 * quad;
#pragma unroll
    for (int rr = 0; rr < 8; ++rr) {
        const bf16_t* kb = kbase0 + (size_t)rr * 64 * HD;
        const bf16x8 k00 = *(const bf16x8*)(kb), k01 = *(const bf16x8*)(kb + 32), k10 = *(const bf16x8*)(kb + 4 * HD), k11 = *(const bf16x8*)(kb + 4 * HD + 32);
        const bf16_t* vb = vbase0 + rr * 64;
        bf16x8 vf[4];
#pragma unroll
        for (int db = 0; db < 4; ++db) vf[db] = *(const bf16x8*)(vb + (size_t)db * 16 * MTOT);
        f32x4 s0 = __builtin_amdgcn_mfma_f32_16x16x32_bf16(k00, qr0, zero4, 0, 0, 0); s0 = __builtin_amdgcn_mfma_f32_16x16x32_bf16(k01, qr1, s0, 0, 0, 0);
        f32x4 s1 = __builtin_amdgcn_mfma_f32_16x16x32_bf16(k10, qr0, zero4, 0, 0, 0); s1 = __builtin_amdgcn_mfma_f32_16x16x32_bf16(k11, qr1, s1, 0, 0, 0);
        const int dr = rs + rr - i + 7;
        const LAS float* tb = btab + (h * 15 + dr) * 64 + dcb;
        float pj[8];
#pragma unroll
        for (int j = 0; j < 8; ++j) { const float sv = (j < 4 ? s0[j] : s1[j - 4]) + tb[j]; const float e = __builtin_amdgcn_exp2f(sv); pj[j] = ((vmask >> j) & 1u) ? e : 0.f; lsum += pj[j]; }
        u32x4 pw; pw.x = cvtpk(pj[0], pj[1]); pw.y = cvtpk(pj[2], pj[3]); pw.z = cvtpk(pj[4], pj[5]); pw.w = cvtpk(pj[6], pj[7]);
        const bf16x8 pb = __builtin_bit_cast(bf16x8, pw);
#pragma unroll
        for (int db = 0; db < 4; ++db) o[db] = __builtin_amdgcn_mfma_f32_16x16x32_bf16(vf[db], pb, o[db], 0, 0, 0);
    }
    const bf16_t* kcb0 = KC + ((size_t)bh * CTXL + krow0) * HD + quad * 8;
    const bf16_t* vcb0 = VT + (size_t)(h * HD + q16) * MTOT + MLAT + b * CTXL + 8 * quad;
#pragma unroll
    for (int cb = 0; cb < 8; ++cb) {
        const bf16_t* kb = kcb0 + (size_t)cb * 32 * HD;
        const bf16x8 k00 = *(const bf16x8*)(kb), k01 = *(const bf16x8*)(kb + 32), k10 = *(const bf16x8*)(kb + 4 * HD), k11 = *(const bf16x8*)(kb + 4 * HD + 32);
        const bf16_t* vb = vcb0 + cb * 32;
        bf16x8 vf[4];
#pragma unroll
        for (int db = 0; db < 4; ++db) vf[db] = *(const bf16x8*)(vb + (size_t)db * 16 * MTOT);
        f32x4 s0 = __builtin_amdgcn_mfma_f32_16x16x32_bf16(k00, qp0, zero4, 0, 0, 0); s0 = __builtin_amdgcn_mfma_f32_16x16x32_bf16(k01, qp1, s0, 0, 0, 0);
        f32x4 s1 = __builtin_amdgcn_mfma_f32_16x16x32_bf16(k10, qp0, zero4, 0, 0, 0); s1 = __builtin_amdgcn_mfma_f32_16x16x32_bf16(k11, qp1, s1, 0, 0, 0);
        float pj[8];
#pragma unroll
        for (int j = 0; j < 8; ++j) { pj[j] = __builtin_amdgcn_exp2f((j < 4 ? s0[j] : s1[j - 4]) - B2); lsum += pj[j]; }
        u32x4 pw; pw.x = cvtpk(pj[0], pj[1]); pw.y = cvtpk(pj[2], pj[3]); pw.z = cvtpk(pj[4], pj[5]); pw.w = cvtpk(pj[6], pj[7]);
        const bf16x8 pb = __builtin_bit_cast(bf16x8, pw);
#pragma unroll
        for (int db = 0; db < 4; ++db) o[db] = __builtin_amdgcn_mfma_f32_16x16x32_bf16(vf[db], pb, o[db], 0, 0, 0);
    }
    lsum += __shfl_xor(lsum, 16); lsum += __shfl_xor(lsum, 32);
    const float inv = 1.0f / lsum;
    const size_t tok = (size_t)b * SEQ + i * 64 + qcol;
#pragma unroll
    for (int db = 0; db < 4; ++db) {
        const int d0 = h * HD + 16 * db + 4 * quad;
        const u32x2 zz = *(const u32x2*)(ZA + tok * 512 + d0);
        const float z0 = __builtin_bit_cast(float, zz.x << 16), z1 = __builtin_bit_cast(float, zz.x & 0xffff0000u), z2 = __builtin_bit_cast(float, zz.y << 16), z3 = __builtin_bit_cast(float, zz.y & 0xffff0000u);
        u32x2 w; w.x = cvtpk(o[db][0] * inv * z0, o[db][1] * inv * z1); w.y = cvtpk(o[db][2] * inv * z2, o[db][3] * inv * z3);
        *(u32x2*)(MIX + tok * DM + d0) = w;
    }
}

__device__ __forceinline__ void phase3(const Params& p, LAS unsigned char* lds) {
    const int tid = threadIdx.x, lane = tid & 63, wave = __builtin_amdgcn_readfirstlane(tid >> 6);
    LAS float* btab = (LAS float*)lds;
    const float B2 = *(const float*)(p.ws + WS_BND);
    for (int idx = tid; idx < NH * 15 * 64; idx += NTHREADS) {
        const int c = idx & 63, hd = idx >> 6; const int dc = min(max(c - 16, 0), 30);
        btab[idx] = p.rpb[hd * 31 + dc] * LOG2E - B2;
    }
    __syncthreads();
    const int G = gridDim.x, x = blockIdx.x & 7, lb = blockIdx.x >> 3, nb = G >> 3;
    for (int li = lb; li < 128; li += nb) {
        const int bh = 8 * x + (li >> 4), ipair = li & 15;
        attn_item(p, btab, B2, bh >> 3, bh & 7, 2 * ipair + (wave >> 2), wave & 3, lane);
    }
    const bf16_t* CG = (const bf16_t*)(p.ws + WS_CG); bf16_t* MIX = (bf16_t*)(p.ws + WS_MIX);
    const int g = tid & 127;
    const f32x4 w0 = *(const f32x4*)(p.conv_w + 4 * g), w1 = *(const f32x4*)(p.conv_w + 512 + 4 * g), w2 = *(const f32x4*)(p.conv_w + 1024 + 4 * g), cb = *(const f32x4*)(p.conv_b + 4 * g);
    for (int tok = blockIdx.x * 4 + (tid >> 7); tok < MLAT; tok += G * 4) {
        const int t = tok & (SEQ - 1);
        const u32x4 cur = *(const u32x4*)(CG + (size_t)tok * 1024 + g * 8);
        u32x2 pv = {0u, 0u}, nv = {0u, 0u};
        if (t > 0) pv = *(const u32x2*)(CG + (size_t)(tok - 1) * 1024 + g * 8);
        if (t < SEQ - 1) nv = *(const u32x2*)(CG + (size_t)(tok + 1) * 1024 + g * 8);
#define LO16(u) __builtin_bit_cast(float, (u) << 16)
#define HI16(u) __builtin_bit_cast(float, (u) & 0xffff0000u)
        const f32x4 cp = {LO16(pv.x), HI16(pv.x), LO16(pv.y), HI16(pv.y)};
        const f32x4 cc = {LO16(cur.x), HI16(cur.x), LO16(cur.y), HI16(cur.y)};
        const f32x4 cn = {LO16(nv.x), HI16(nv.x), LO16(nv.y), HI16(nv.y)};
        const f32x4 gz = {LO16(cur.z), HI16(cur.z), LO16(cur.w), HI16(cur.w)};
#undef LO16
#undef HI16
        const f32x4 y = gz * (cb + w0 * cp + w1 * cc + w2 * cn);
        u32x2 w; w.x = cvtpk(y[0], y[1]); w.y = cvtpk(y[2], y[3]);
        *(u32x2*)(MIX + (size_t)tok * DM + 512 + 4 * g) = w;
    }
}

__global__ void __launch_bounds__(NTHREADS, 2) fwd_megakernel(Params p) {
    extern __shared__ __attribute__((aligned(16))) unsigned char lds_raw[];
    LAS unsigned char* lds = (LAS unsigned char*)lds_raw;
    cg::grid_group grid = cg::this_grid();
    const int lo = p.ph_lo, hi = p.ph_hi;
    const int x = blockIdx.x & 7, lb = blockIdx.x >> 3, nb = gridDim.x >> 3;
    EpiCtx E;
    E.QP = (bf16_t*)(p.ws + WS_QP); E.QR = (bf16_t*)(p.ws + WS_QR); E.KR = (bf16_t*)(p.ws + WS_KR); E.KC = (bf16_t*)(p.ws + WS_KC);
    E.VT = (bf16_t*)(p.ws + WS_VT); E.ZA = (bf16_t*)(p.ws + WS_ZA); E.CG = (bf16_t*)(p.ws + WS_CG);
    E.gq = p.q_norm_g; E.gk = p.k_norm_g; E.rope = (const float*)(p.ws + WS_ROPE);
    E.x = p.x; E.gate = (const float*)(p.ws + WS_GATE); E.out = p.out;
#define IN(k) (lo <= (k) && (k) < hi)
#define SEAM(k) do { if (IN(k) && IN((k) + 1)) grid.sync(); } while (0)
    if (IN(0)) phase0(p, lds);
    SEAM(0);
    if (IN(1)) phase1(p, lds);
    SEAM(1);
    if (IN(2)) { SchedP2 S{x, lb, nb, (const char*)(p.ws + WS_XN), (const char*)(p.ws + WS_WT)}; gemm_phase<2>(lds, S, E); }
    SEAM(2);
    if (IN(3)) phase3(p, lds);
    SEAM(3);
    if (IN(4)) { SchedP4 S{x, lb, nb, (const char*)(p.ws + WS_MIX), (const char*)(p.ws + WS_WO)}; gemm_phase<4>(lds, S, E); }
#undef IN
#undef SEAM
}

extern "C" void kernel_launch(void* const* d_in, const int* in_sizes, int n_in, void* d_out, int out_size, void* d_ws, size_t ws_size, hipStream_t stream) {
    static int grid = 0;
    if (grid == 0) {
        int dev = 0, cus = 0, per_cu = 0;
        hipGetDevice(&dev);
        hipDeviceGetAttribute(&cus, hipDeviceAttributeMultiprocessorCount, dev);
        if (hipFuncSetAttribute((const void*)fwd_megakernel, hipFuncAttributeMaxDynamicSharedMemorySize, LDS_BYTES) != hipSuccess) { fprintf(stderr, "hipFuncSetAttribute failed\n"); grid = -1; return; }
        hipOccupancyMaxActiveBlocksPerMultiprocessor(&per_cu, (const void*)fwd_megakernel, NTHREADS, LDS_BYTES);
        if (per_cu < 1) { fprintf(stderr, "occupancy query says %d blocks per CU\n", per_cu); grid = -1; return; }
        grid = cus;
        grid -= grid % 8;
        if (n_in != 14 || ws_size < WS_END || grid < 8) { fprintf(stderr, "unexpected problem geometry\n"); grid = -1; return; }
    }
    if (grid < 0) return;
    Params p{};
    p.x = (const float*)d_in[0]; p.c = (const float*)d_in[1]; p.ctx = (const float*)d_in[2]; p.c_ctx = (const float*)d_in[3];
    p.w_ada = (const float*)d_in[4]; p.b_ada = (const float*)d_in[5]; p.norm_g = (const float*)d_in[6]; p.w_in = (const float*)d_in[7];
    p.q_norm_g = (const float*)d_in[8]; p.k_norm_g = (const float*)d_in[9]; p.rpb = (const float*)d_in[10]; p.conv_w = (const float*)d_in[11];
    p.conv_b = (const float*)d_in[12]; p.w_out = (const float*)d_in[13];
    p.out = (float*)d_out; p.ws = (unsigned char*)d_ws;
#if N_LAUNCH_MODE == 1
    p.ph_lo = 0; p.ph_hi = 5;
    void* args[] = {&p};
    hipError_t e = hipLaunchCooperativeKernel((const void*)fwd_megakernel, dim3(grid), dim3(NTHREADS), args, LDS_BYTES, stream);
    if (e != hipSuccess) fprintf(stderr, "cooperative launch failed: %s (grid %d)\n", hipGetErrorString(e), grid);
#else
    for (int ph = 0; ph < 5; ++ph) {
        p.ph_lo = ph; p.ph_hi = ph + 1;
        hipLaunchKernelGGL(fwd_megakernel, dim3(grid), dim3(NTHREADS), LDS_BYTES, stream, p);
    }
#endif
}
```

```cpp
#include <hip/hip_runtime.h>
#include <hip/hip_cooperative_groups.h>
#include <cstdio>
#include <cstdint>
namespace cg = cooperative_groups;

#ifndef N_LAUNCH_MODE
#define N_LAUNCH_MODE 1
#endif

#define LAS __attribute__((address_space(3)))
typedef unsigned short bf16_t;
typedef short bf16x8 __attribute__((ext_vector_type(8)));
typedef float f32x4 __attribute__((ext_vector_type(4)));
typedef float f32x2 __attribute__((ext_vector_type(2)));
typedef unsigned u32x4 __attribute__((ext_vector_type(4)));
typedef unsigned u32x2 __attribute__((ext_vector_type(2)));
typedef __bf16 bf16x2_t __attribute__((ext_vector_type(2)));

constexpr int NBATCH = 8, SEQ = 2048, DM = 1024, CTXL = 256, NH = 8, HD = 64;
constexpr int MLAT = NBATCH * SEQ, MCTX = NBATCH * CTXL, MTOT = MLAT + MCTX;
constexpr int DIN = 4096, NADA = 3072;
constexpr float RMS_EPS = 1e-6f;
constexpr float LOG2E = 1.4426950408889634f;

constexpr size_t MiB = 1u << 20;
constexpr size_t WS_WT = 0;
constexpr size_t WS_WO = 8 * MiB;
constexpr size_t WS_ADAP = 10 * MiB;
constexpr size_t WS_GATE = 11 * MiB;
constexpr size_t WS_ROPE = 11 * MiB + 65536;
constexpr size_t WS_BND = 11 * MiB + 131072;
constexpr size_t WS_XN = 12 * MiB;
constexpr size_t WS_QP = 48 * MiB;
constexpr size_t WS_QR = 64 * MiB;
constexpr size_t WS_KR = 80 * MiB;
constexpr size_t WS_KC = 96 * MiB;
constexpr size_t WS_VT = 98 * MiB;
constexpr size_t WS_ZA = 116 * MiB;
constexpr size_t WS_CG = 132 * MiB;
constexpr size_t WS_MIX = 164 * MiB;
constexpr size_t WS_END = 196 * MiB;

constexpr int LDS_BYTES = 147456;
constexpr int NTHREADS = 512;

struct Params {
    const float *x, *c, *ctx, *c_ctx, *w_ada, *b_ada, *norm_g, *w_in, *q_norm_g, *k_norm_g, *rpb, *conv_w, *conv_b, *w_out;
    float* out; unsigned char* ws; int ph_lo, ph_hi;
};

__device__ __forceinline__ unsigned cvtpk(float lo, float hi) { f32x2 v = {lo, hi}; bf16x2_t b = __builtin_convertvector(v, bf16x2_t); return __builtin_bit_cast(unsigned, b); }
__device__ __forceinline__ float bf2f(unsigned short h) { return __builtin_bit_cast(float, (unsigned)h << 16); }
__device__ __forceinline__ float silu_f(float v) { return v * __builtin_amdgcn_rcpf(1.0f + __builtin_amdgcn_exp2f(-v * LOG2E)); }
__device__ __forceinline__ float wave_sum(float v) {
#pragma unroll
    for (int o = 1; o < 64; o <<= 1) v += __shfl_xor(v, o);
    return v;
}

constexpr int BM = 256, BK = 64, HALF = 128, HTB = HALF * BK * 2, KDIM = 1024;
constexpr size_t TSTEP = (size_t)BM * KDIM * 2;
__device__ __forceinline__ int lds_byte(int r, int c) { const int st = (r >> 4) * 2 + (c >> 5), rr = r & 15, cc = c & 31, ob = rr * 64 + cc * 2; return st * 1024 + (ob ^ (((ob >> 9) & 1) << 5)); }
__device__ __forceinline__ void stage_rc(int b, int& R, int& C) { const int st = b / 1024, sb = b % 1024, swz = sb ^ (((sb >> 9) & 1) << 5); R = (st >> 1) * 16 + swz / 64; C = (st & 1) * 32 + (swz % 64) / 2; }
__device__ __forceinline__ int perm32(int rho) { const int n = rho >> 4, i = rho & 15; return 8 * (i >> 2) + 4 * n + (i & 3); }

struct Unit { const char* a; const char* b; int kind, pm, pn; };

struct EpiCtx {
    bf16_t *QP, *QR, *KR, *KC, *VT, *ZA, *CG;
    const float *gq, *gk, *rope;
    const float *x, *gate; float* out;
};

template <int PH>
__device__ __forceinline__ void epilogue(const f32x4 (&acc)[2][2][4][2], const Unit& u, int wr, int wc, int fr, int fq, const EpiCtx& E) {
    if constexpr (PH == 4) {
        const int b = (u.pm * BM) >> 11;
        const int c0 = u.pn * BM + wc * 32 + fq * 8;
        f32x4 gv[2][2];
#pragma unroll
        for (int bj = 0; bj < 2; ++bj)
#pragma unroll
            for (int n = 0; n < 2; ++n) gv[bj][n] = *(const f32x4*)(E.gate + b * DM + c0 + bj * HALF + 4 * n);
#pragma unroll
        for (int ai = 0; ai < 2; ++ai)
#pragma unroll
            for (int m = 0; m < 4; ++m) {
                const size_t off = (size_t)(u.pm * BM + ai * HALF + wr * 64 + m * 16 + fr) * DM + c0;
#pragma unroll
                for (int bj = 0; bj < 2; ++bj)
#pragma unroll
                    for (int n = 0; n < 2; ++n) {
                        const f32x4 xv = *(const f32x4*)(E.x + off + bj * HALF + 4 * n);
                        *(f32x4*)(E.out + off + bj * HALF + 4 * n) = xv + gv[bj][n] * acc[ai][bj][m][n];
                    }
            }
    } else {
        const int kind = u.kind;
        if (kind == 0 || kind == 1 || kind == 5) {
            const bool isq = (kind == 0);
            const float* g = isq ? E.gq : E.gk;
            const float qs = isq ? 0.125f * LOG2E : 1.0f;
            const int head = 4 * (u.pn & 1) + wc;
            f32x4 gv[2][2];
#pragma unroll
            for (int bj = 0; bj < 2; ++bj)
#pragma unroll
                for (int n = 0; n < 2; ++n) gv[bj][n] = *(const f32x4*)(g + 32 * bj + 16 * n + 4 * fq);
#pragma unroll
            for (int ai = 0; ai < 2; ++ai)
#pragma unroll
                for (int m = 0; m < 4; ++m) {
                    const int r = u.pm * BM + ai * HALF + wr * 64 + m * 16 + fr;
                    f32x4 v[2][2]; float ss = 0.f;
#pragma unroll
                    for (int bj = 0; bj < 2; ++bj)
#pragma unroll
                        for (int n = 0; n < 2; ++n) { v[bj][n] = acc[ai][bj][m][n]; const f32x4 t = v[bj][n] * v[bj][n]; ss += (t[0] + t[1]) + (t[2] + t[3]); }
                    ss += __shfl_xor(ss, 16); ss += __shfl_xor(ss, 32);
                    const float rinv = __builtin_amdgcn_rsqf(ss * (1.0f / 64.0f) + RMS_EPS) * qs;
#pragma unroll
                    for (int bj = 0; bj < 2; ++bj)
#pragma unroll
                        for (int n = 0; n < 2; ++n) v[bj][n] = v[bj][n] * rinv * gv[bj][n];
                    if (kind == 5) {
                        const int rc = r - MLAT, b = rc >> 8, l = rc & 255;
                        bf16_t* dst = E.KC + ((size_t)((b * NH + head) * CTXL + l)) * HD + fq * 16;
#pragma unroll
                        for (int bj = 0; bj < 2; ++bj) { u32x4 w; w.x = cvtpk(v[bj][0][0], v[bj][0][1]); w.y = cvtpk(v[bj][0][2], v[bj][0][3]); w.z = cvtpk(v[bj][1][0], v[bj][1][1]); w.w = cvtpk(v[bj][1][2], v[bj][1][3]); *(u32x4*)(dst + bj * 8) = w; }
                    } else {
                        const int b = r >> 11, t = r & 2047, grow = t >> 6, gcol = t & 63;
                        const size_t rowoff = ((size_t)((b * NH + head) * SEQ + t)) * HD + fq * 16;
                        if (isq) {
                            bf16_t* dst = E.QP + rowoff;
#pragma unroll
                            for (int bj = 0; bj < 2; ++bj) { u32x4 w; w.x = cvtpk(v[bj][0][0], v[bj][0][1]); w.y = cvtpk(v[bj][0][2], v[bj][0][3]); w.z = cvtpk(v[bj][1][0], v[bj][1][1]); w.w = cvtpk(v[bj][1][2], v[bj][1][3]); *(u32x4*)(dst + bj * 8) = w; }
                        }
                        bf16_t* dst = (isq ? E.QR : E.KR) + rowoff;
#pragma unroll
                        for (int bj = 0; bj < 2; ++bj) {
                            const int pos = bj ? gcol : grow;
                            const f32x4 cs = *(const f32x4*)(E.rope + pos * 16 + 4 * fq), sn = *(const f32x4*)(E.rope + 1024 + pos * 16 + 4 * fq);
                            const f32x4 o0 = v[bj][0] * cs - v[bj][1] * sn, o1 = v[bj][1] * cs + v[bj][0] * sn;
                            u32x4 w; w.x = cvtpk(o0[0], o0[1]); w.y = cvtpk(o0[2], o0[3]); w.z = cvtpk(o1[0], o1[1]); w.w = cvtpk(o1[2], o1[3]);
                            *(u32x4*)(dst + bj * 8) = w;
                        }
                    }
                }
        } else if (kind == 2) {
            const int c0 = (u.pn - 6) * BM + wc * 32 + fq * 8;
#pragma unroll
            for (int ai = 0; ai < 2; ++ai)
#pragma unroll
                for (int m = 0; m < 4; ++m) {
                    bf16_t* dst = E.ZA + (size_t)(u.pm * BM + ai * HALF + wr * 64 + m * 16 + fr) * 512 + c0;
#pragma unroll
                    for (int bj = 0; bj < 2; ++bj) {
                        const f32x4 a0 = acc[ai][bj][m][0], a1 = acc[ai][bj][m][1];
                        u32x4 w; w.x = cvtpk(silu_f(a0[0]), silu_f(a0[1])); w.y = cvtpk(silu_f(a0[2]), silu_f(a0[3])); w.z = cvtpk(silu_f(a1[0]), silu_f(a1[1])); w.w = cvtpk(silu_f(a1[2]), silu_f(a1[3]));
                        *(u32x4*)(dst + bj * HALF) = w;
                    }
                }
        } else if (kind == 3) {
            const int ch0 = (u.pn - 8) * 64 + wc * 16 + fq * 4;
#pragma unroll
            for (int ai = 0; ai < 2; ++ai)
#pragma unroll
                for (int m = 0; m < 4; ++m) {
                    const f32x4 uu = acc[ai][0][m][0], bg = acc[ai][0][m][1], cgv = acc[ai][1][m][0], zc = acc[ai][1][m][1];
                    const f32x4 cu = cgv * uu;
                    f32x4 gz;
#pragma unroll
                    for (int j = 0; j < 4; ++j) gz[j] = bg[j] * silu_f(zc[j]);
                    u32x4 w; w.x = cvtpk(cu[0], cu[1]); w.y = cvtpk(cu[2], cu[3]); w.z = cvtpk(gz[0], gz[1]); w.w = cvtpk(gz[2], gz[3]);
                    *(u32x4*)(E.CG + (size_t)(u.pm * BM + ai * HALF + wr * 64 + m * 16 + fr) * 1024 + ch0 * 2) = w;
                }
        } else {
            const int c0 = u.pn * BM + wc * 32 + fq * 8;
#pragma unroll
            for (int ai = 0; ai < 2; ++ai)
#pragma unroll
                for (int m = 0; m < 4; ++m) {
                    bf16_t* dst = E.VT + (size_t)(u.pm * BM + ai * HALF + wr * 64 + m * 16 + fr) * MTOT + c0;
#pragma unroll
                    for (int bj = 0; bj < 2; ++bj) {
                        const f32x4 a0 = acc[ai][bj][m][0], a1 = acc[ai][bj][m][1];
                        u32x4 w; w.x = cvtpk(a0[0], a0[1]); w.y = cvtpk(a0[2], a0[3]); w.z = cvtpk(a1[0], a1[1]); w.w = cvtpk(a1[2], a1[3]);
                        *(u32x4*)(dst + bj * HALF) = w;
                    }
                }
        }
    }
}

struct SchedP2 {
    int x, lb, nb; const char* XN; const char* WT;
    __device__ __forceinline__ bool next(int i, Unit& u) const {
        const int uu = lb + i * nb; if (uu >= 132) return false;
        if (uu < 112) {
            const int pi = uu >> 3, pm = 8 * x + (uu & 7), pn = pi < 4 ? pi : pi + 2;
            u.kind = pn < 2 ? 0 : (pn < 4 ? 1 : (pn < 8 ? 2 : 3)); u.pm = pm; u.pn = pn; u.a = XN + (size_t)pm * TSTEP; u.b = WT + (size_t)pn * TSTEP;
        } else if (uu < 130) {
            const int v = uu - 112, pnp = 9 * x + v % 9, pmp = v / 9;
            u.kind = 4; u.pm = pmp; u.pn = pnp; u.a = WT + (size_t)(4 + pmp) * TSTEP; u.b = XN + (size_t)pnp * TSTEP;
        } else {
            u.kind = 5; u.pm = 64 + x; u.pn = 2 + (uu - 130); u.a = XN + (size_t)u.pm * TSTEP; u.b = WT + (size_t)u.pn * TSTEP;
        }
        return true;
    }
};
struct SchedP4 {
    int x, lb, nb; const char* MIX; const char* WO;
    __device__ __forceinline__ bool next(int i, Unit& u) const {
        const int uu = lb + i * nb; if (uu >= 32) return false;
        u.kind = 6; u.pm = 8 * x + (uu & 7); u.pn = uu >> 3; u.a = MIX + (size_t)u.pm * TSTEP; u.b = WO + (size_t)u.pn * TSTEP; return true;
    }
};

template <int PH, class Sched>
__device__ __forceinline__ void gemm_phase(LAS unsigned char* lds, const Sched& S, const EpiCtx& E) {
    const int tid = threadIdx.x, wid = __builtin_amdgcn_readfirstlane(tid >> 6), lane = tid & 63, wr = wid >> 2, wc = wid & 3, fr = lane & 15, fq = lane >> 4;
    constexpr int K = KDIM, nt = K / BK;
    unsigned voffA[2], voffB[2];
#pragma unroll
    for (int i = 0; i < 2; ++i) { int R, C; stage_rc(tid * 16 + i * 8192, R, C); const int Rb = (R & ~31) + perm32(R & 31);
        voffA[i] = (unsigned)(R * K + C) * 2u; voffB[i] = (unsigned)(Rb * K + C) * 2u; }
    const size_t kstep = (size_t)(BK * 2);
    const size_t hstep = (size_t)HALF * K * 2;
    const unsigned ldsw = (unsigned)wid * 1024u;
    const int aoff = lds_byte(wr * 64 + fr, fq * 8), boff = lds_byte(wc * 32 + fr, fq * 8);
#define PG8_SA(b, h) (((b) * 2 + (h)) * HTB)
#define PG8_SB(b, h) ((4 + (b) * 2 + (h)) * HTB)
#define PG8_STAGE(bufoff, gbase, voff) do { _Pragma("unroll") for (int _i = 0; _i < 2; ++_i) \
        __builtin_amdgcn_global_load_lds((const unsigned*)((const char*)(gbase) + (voff)[_i]), (LAS unsigned*)(lds + (bufoff) + ldsw + _i * 8192), 16, 0, 0); } while (0)
#define PG8_LDA(dst, b, h) do { _Pragma("unroll") for (int m = 0; m < 4; ++m) _Pragma("unroll") for (int k = 0; k < 2; ++k) dst[m][k] = *(const LAS bf16x8*)(lds + PG8_SA(b, h) + aoff + m * 2048 + k * 1024); } while (0)
#define PG8_LDB(dst, b, h) do { _Pragma("unroll") for (int n = 0; n < 2; ++n) _Pragma("unroll") for (int k = 0; k < 2; ++k) dst[n][k] = *(const LAS bf16x8*)(lds + PG8_SB(b, h) + boff + n * 2048 + k * 1024); } while (0)
#define PG8_MMA(ai, bj, At, Bt) do { __builtin_amdgcn_s_setprio(1); _Pragma("unroll") for (int m = 0; m < 4; ++m) _Pragma("unroll") for (int n = 0; n < 2; ++n) _Pragma("unroll") for (int k = 0; k < 2; ++k) \
        acc[ai][bj][m][n] = __builtin_amdgcn_mfma_f32_16x16x32_bf16(Bt[n][k], At[m][k], acc[ai][bj][m][n], 0, 0, 0); __builtin_amdgcn_s_setprio(0); } while (0)
#define PG8_WAIT_V(n) asm volatile("s_waitcnt vmcnt(" #n ")" ::: "memory")
#define PG8_WAIT_L(n) asm volatile("s_waitcnt lgkmcnt(" #n ")" ::: "memory")
#define PG8_BAR __builtin_amdgcn_s_barrier()
#define PG8_SCHED __builtin_amdgcn_sched_barrier(0)
    Unit cur, nxt; int ui = 0;
    if (!S.next(0, cur)) return;
    f32x4 acc[2][2][4][2];
#pragma unroll
    for (int a = 0; a < 2; ++a)
#pragma unroll
        for (int b = 0; b < 2; ++b)
#pragma unroll
            for (int m = 0; m < 4; ++m)
#pragma unroll
                for (int n = 0; n < 2; ++n) acc[a][b][m][n] = (f32x4){0.f, 0.f, 0.f, 0.f};
    bf16x8 At[4][2], B0[2][2], B1[2][2];
    const char* cA = cur.a; const char* cB = cur.b;
    PG8_STAGE(PG8_SB(0, 0), cB, voffB); PG8_STAGE(PG8_SB(0, 1), cB + hstep, voffB); PG8_STAGE(PG8_SA(0, 0), cA, voffA); PG8_STAGE(PG8_SA(0, 1), cA + hstep, voffA);
    if (wr == 1) PG8_BAR;
    PG8_WAIT_V(2); PG8_BAR;
    PG8_STAGE(PG8_SB(1, 0), cB + kstep, voffB); PG8_STAGE(PG8_SA(1, 0), cA + kstep, voffA); PG8_STAGE(PG8_SB(1, 1), cB + hstep + kstep, voffB);
    PG8_WAIT_V(6); PG8_BAR;
    for (;;) {
        const bool has_next = S.next(ui + 1, nxt);
        const char* nA = has_next ? nxt.a : cA; const char* nB = has_next ? nxt.b : cB;
        for (int t = 0; t < nt; t += 2) {
            const bool last = (t == nt - 2);
            const char* a1 = cA + (size_t)(t + 1) * kstep;
            const char* a2 = last ? nA : cA + (size_t)(t + 2) * kstep; const char* b2 = last ? nB : cB + (size_t)(t + 2) * kstep;
            const char* a3 = a2 + kstep; const char* b3 = b2 + kstep;
            PG8_LDB(B0, 0, 0); PG8_LDB(B1, 0, 1); PG8_SCHED; PG8_LDA(At, 0, 0); PG8_STAGE(PG8_SA(1, 1), a1 + hstep, voffA);
            PG8_WAIT_V(8); PG8_WAIT_L(0); PG8_BAR; PG8_MMA(0, 0, At, B0); PG8_MMA(0, 1, At, B1); PG8_BAR; PG8_SCHED;
            PG8_LDA(At, 0, 1); PG8_STAGE(PG8_SB(0, 0), b2, voffB); PG8_STAGE(PG8_SB(0, 1), b2 + hstep, voffB); PG8_STAGE(PG8_SA(0, 0), a2, voffA);
            PG8_WAIT_V(8); PG8_WAIT_L(0); PG8_BAR; PG8_MMA(1, 0, At, B0); PG8_MMA(1, 1, At, B1); PG8_BAR; PG8_SCHED;
            PG8_LDB(B0, 1, 0); PG8_LDB(B1, 1, 1); PG8_SCHED; PG8_LDA(At, 1, 0); PG8_STAGE(PG8_SA(0, 1), a2 + hstep, voffA);
            PG8_WAIT_V(8); PG8_WAIT_L(0); PG8_BAR; PG8_MMA(0, 0, At, B0); PG8_MMA(0, 1, At, B1); PG8_BAR; PG8_SCHED;
            PG8_LDA(At, 1, 1); PG8_STAGE(PG8_SB(1, 0), b3, voffB); PG8_STAGE(PG8_SB(1, 1), b3 + hstep, voffB); PG8_STAGE(PG8_SA(1, 0), a3, voffA);
            PG8_WAIT_V(8); PG8_WAIT_L(0); PG8_BAR; PG8_MMA(1, 0, At, B0); PG8_MMA(1, 1, At, B1); PG8_BAR; PG8_SCHED;
        }
        if (wr == 0) PG8_BAR;
        epilogue<PH>(acc, cur, wr, wc, fr, fq, E);
        if (!has_next) break;
#pragma unroll
        for (int a = 0; a < 2; ++a)
#pragma unroll
            for (int b = 0; b < 2; ++b)
#pragma unroll
                for (int m = 0; m < 4; ++m)
#pragma unroll
                    for (int n = 0; n < 2; ++n) acc[a][b][m][n] = (f32x4){0.f, 0.f, 0.f, 0.f};
        cur = nxt; cA = nA; cB = nB; ++ui;
        if (wr == 1) PG8_BAR;
    }
    PG8_WAIT_V(0);
    PG8_BAR;
#undef PG8_SA
#undef PG8_SB
#undef PG8_STAGE
#undef PG8_LDA
#undef PG8_LDB
#undef PG8_MMA
#undef PG8_WAIT_V
#undef PG8_WAIT_L
#undef PG8_BAR
#undef PG8_SCHED
}

__device__ __forceinline__ int wt_dst_row(int c) {
    if (c < 1024) {
        const int base = c & ~511, local = c & 511, head = local >> 6, d = local & 63;
        const int pnl = head >> 2, wc = head & 3, bj = d >> 5, n = (d >> 4) & 1, f = d & 15, fq = f >> 2, j = f & 3;
        return base + pnl * 256 + 128 * bj + 32 * wc + 8 * fq + 4 * n + j;
    } else if (c < 2048) {
        return c;
    } else {
        const int type = (c - 2048) >> 9, ch = (c - 2048) & 511, ct = ch >> 6, chl = ch & 63;
        const int wc = chl >> 4, fq = (chl >> 2) & 3, j = chl & 3, bj = type >> 1, n = type & 1;
        return 2048 + ct * 256 + 128 * bj + 32 * wc + 8 * fq + 4 * n + j;
    }
}
template <bool PERMUTE>
__device__ __forceinline__ void p0_transpose_item(const float* W, int N, bf16_t* WT, LAS float* scr, int item, int lane) {
    const int nblk = N / 32, kb = item / nblk, nb = item % nblk, k0 = 64 * kb, n0 = 32 * nb;
#pragma unroll 8
    for (int i = 0; i < 32; ++i) { const int kk = 2 * i + (lane >> 5); scr[kk * 33 + (lane & 31)] = W[(size_t)(k0 + kk) * N + n0 + (lane & 31)]; }
    asm volatile("s_waitcnt lgkmcnt(0)" ::: "memory");
    const int c = lane & 7;
#pragma unroll
    for (int j = 0; j < 4; ++j) { const int n = (lane >> 3) + 8 * j; const LAS float* s = scr + (8 * c) * 33 + n;
        u32x4 o; o.x = cvtpk(s[0 * 33], s[1 * 33]); o.y = cvtpk(s[2 * 33], s[3 * 33]); o.z = cvtpk(s[4 * 33], s[5 * 33]); o.w = cvtpk(s[6 * 33], s[7 * 33]);
        const int drow = PERMUTE ? wt_dst_row(n0 + n) : (n0 + n);
        *(u32x4*)(WT + (size_t)drow * KDIM + k0 + 8 * c) = o; }
    asm volatile("s_waitcnt lgkmcnt(0)" ::: "memory");
}

__device__ __forceinline__ void phase0(const Params& p, LAS unsigned char* lds) {
    const int tid = threadIdx.x, lane = tid & 63, wave = __builtin_amdgcn_readfirstlane(tid >> 6);
    const int G = gridDim.x;
    LAS float* sc = (LAS float*)lds;
    LAS float* scr = (LAS float*)(lds + 40960 + wave * 8704);
    for (int idx = tid; idx < 9 * 1024; idx += NTHREADS) { const float v = idx < 8192 ? p.c[idx] : p.c_ctx[idx - 8192]; sc[idx] = v * (1.0f / (1.0f + __expf(-v))); }
    __syncthreads();
    bf16_t* WT = (bf16_t*)(p.ws + WS_WT); bf16_t* WO = (bf16_t*)(p.ws + WS_WO);
    float* ADAP = (float*)(p.ws + WS_ADAP);
    const int gw = wave * G + blockIdx.x, NGW = G * 8;
    constexpr int N_ADA = 768, N_TIN = (KDIM / 64) * (DIN / 32), N_TOUT = (KDIM / 64) * (DM / 32);
    for (int it = gw; it < N_ADA + N_TIN + N_TOUT; it += NGW) {
        if (it < N_ADA) {
            const int cgp = it % 96, kc = it / 96, col = cgp * 32 + (lane & 31), k0 = kc * 128 + (lane >> 5) * 64;
            float a[9];
#pragma unroll
            for (int r = 0; r < 9; ++r) a[r] = 0.f;
#pragma unroll 8
            for (int kk = 0; kk < 64; ++kk) {
                const float w = p.w_ada[(size_t)(k0 + kk) * NADA + col];
#pragma unroll
                for (int r = 0; r < 9; ++r) a[r] += sc[r * 1024 + k0 + kk] * w;
            }
#pragma unroll
            for (int r = 0; r < 9; ++r) { a[r] += __shfl_xor(a[r], 32); if (lane < 32) ADAP[(size_t)(kc * 9 + r) * NADA + col] = a[r]; }
        } else if (it < N_ADA + N_TIN) {
            p0_transpose_item<true>(p.w_in, DIN, WT, scr, it - N_ADA, lane);
        } else {
            p0_transpose_item<false>(p.w_out, DM, WO, scr, it - N_ADA - N_TIN, lane);
        }
    }
    if (blockIdx.x == 0) {
        float* rope = (float*)(p.ws + WS_ROPE);
        if (tid < 16) {
            double inv = 1.0; for (int i = 0; i < tid; ++i) inv *= 0.5623413251903491;
            const double a = (double)(float)inv;
            double s = 0.0, c = 0.0, term = 1.0;
            for (int n = 0; n < 24; ++n) { if ((n & 1) == 0) c += ((n & 2) ? -term : term); else s += ((n & 2) ? -term : term); term *= a / (double)(n + 1); }
            double cp = 1.0, sp = 0.0;
            for (int pos = 0; pos < 64; ++pos) { rope[pos * 16 + tid] = (float)cp; rope[1024 + pos * 16 + tid] = (float)sp; const double cn = cp * c - sp * s, sn = sp * c + cp * s; cp = cn; sp = sn; }
        }
        if (wave == 1) {
            float mq = fabsf(p.q_norm_g[lane]), mk = fabsf(p.k_norm_g[lane]), mr = 0.f;
            for (int i = lane; i < NH * 15 * 31; i += 64) mr = fmaxf(mr, fabsf(p.rpb[i]));
#pragma unroll
            for (int o = 1; o < 64; o <<= 1) { mq = fmaxf(mq, __shfl_xor(mq, o)); mk = fmaxf(mk, __shfl_xor(mk, o)); mr = fmaxf(mr, __shfl_xor(mr, o)); }
            if (lane == 0) *(float*)(p.ws + WS_BND) = (8.0f * mq * mk + mr) * LOG2E;
        }
    }
}

__device__ __forceinline__ void phase1(const Params& p, LAS unsigned char* lds) {
    const int tid = threadIdx.x, lane = tid & 63, wave = __builtin_amdgcn_readfirstlane(tid >> 6);
    LAS float* mult = (LAS float*)lds; LAS float* shf = (LAS float*)(lds + 4096);
    const float* ADAP = (const float*)(p.ws + WS_ADAP);
    bf16_t* XN = (bf16_t*)(p.ws + WS_XN); float* GATE = (float*)(p.ws + WS_GATE);
    for (int chunk = blockIdx.x; chunk < 288; chunk += gridDim.x) {
        const bool lat = chunk < 256; const int ci = lat ? (chunk >> 5) : 8;
        __syncthreads();
        for (int k = tid; k < 1024; k += NTHREADS) {
            float sh = p.b_ada[k], scl = p.b_ada[1024 + k];
#pragma unroll
            for (int kc = 0; kc < 8; ++kc) { sh += ADAP[(size_t)(kc * 9 + ci) * NADA + k]; scl += ADAP[(size_t)(kc * 9 + ci) * NADA + 1024 + k]; }
            mult[k] = p.norm_g[k] * (1.0f + scl); shf[k] = sh;
            if (lat && (chunk & 31) == 0) {
                float gt = p.b_ada[2048 + k];
#pragma unroll
                for (int kc = 0; kc < 8; ++kc) gt += ADAP[(size_t)(kc * 9 + ci) * NADA + 2048 + k];
                GATE[ci * DM + k] = gt;
            }
        }
        __syncthreads();
        const float* src = lat ? p.x + (size_t)chunk * 64 * DM : p.ctx + (size_t)(chunk - 256) * 64 * DM;
        bf16_t* dst = XN + (size_t)chunk * 64 * DM;
        for (int rr = wave; rr < 64; rr += 8) {
            const f32x4* xr = (const f32x4*)(src + (size_t)rr * DM) + lane;
            f32x4 v[4]; float s = 0.f;
#pragma unroll
            for (int j = 0; j < 4; ++j) { v[j] = xr[64 * j]; const f32x4 t = v[j] * v[j]; s += (t[0] + t[1]) + (t[2] + t[3]); }
            const float rinv = __builtin_amdgcn_rsqf(wave_sum(s) * (1.0f / DM) + RMS_EPS);
            u32x2* o8 = (u32x2*)(dst + (size_t)rr * DM) + lane;
#pragma unroll
            for (int j = 0; j < 4; ++j) {
                const f32x4 mu = *(const LAS f32x4*)(mult + 4 * lane + 256 * j), sv = *(const LAS f32x4*)(shf + 4 * lane + 256 * j);
                const f32x4 h = v[j] * rinv * mu + sv;
                u32x2 w; w.x = cvtpk(h[0], h[1]); w.y = cvtpk(h[2], h[3]); o8[64 * j] = w;
            }
        }
    }
}

__device__ __forceinline__ void attn_item(const Params& p, const LAS float* btab, float B2, int b, int h, int i, int qc, int lane) {
    const bf16_t* QP = (const bf16_t*)(p.ws + WS_QP); const bf16_t* QR = (const bf16_t*)(p.ws + WS_QR);
    const bf16_t* KR = (const bf16_t*)(p.ws + WS_KR); const bf16_t* KC = (const bf16_t*)(p.ws + WS_KC);
    const bf16_t* VT = (const bf16_t*)(p.ws + WS_VT); const bf16_t* ZA = (const bf16_t*)(p.ws + WS_ZA);
    bf16_t* MIX = (bf16_t*)(p.ws + WS_MIX);
    const int q16 = lane & 15, quad = lane >> 4, bh = b * NH + h;
    const int qcol = qc * 16 + q16;
    const size_t qoff = ((size_t)bh * SEQ + i * 64 + qcol) * HD + quad * 8;
    const bf16x8 qr0 = *(const bf16x8*)(QR + qoff), qr1 = *(const bf16x8*)(QR + qoff + 32);
    const bf16x8 qp0 = *(const bf16x8*)(QP + qoff), qp1 = *(const bf16x8*)(QP + qoff + 32);
    const int rs = min(max(i - 4, 0), 24);
    const int cs = (qc == 0) ? 0 : (qc == 1) ? 8 : (qc == 2) ? 24 : 32;
    const int lo = min(max(qcol - 8, 0), 48);
    const int kcol0 = cs + 8 * quad;
    const int dcb = kcol0 - qcol + 15 + 16;
    unsigned vmask = 0;
#pragma unroll
    for (int j = 0; j < 8; ++j) { const int kc = kcol0 + j; if (kc >= lo && kc < lo + 16) vmask |= (1u << j); }
    const int krow0 = 8 * (q16 >> 2) + (q16 & 3);
    f32x4 o[4];
#pragma unroll
    for (int db = 0; db < 4; ++db) o[db] = (f32x4){0.f, 0.f, 0.f, 0.f};
    float lsum = 0.f;
    const f32x4 zero4 = {0.f, 0.f, 0.f, 0.f};
    const bf16_t* kbase0 = KR + ((size_t)bh * SEQ + rs * 64 + cs + krow0) * HD + quad * 8;
    const bf16_t* vbase0 = VT + (size_t)(h * HD + q16) * MTOT + b * SEQ + rs * 64 + cs + 8 * quad;
#pragma unroll
    for (int rr = 0; rr < 8; ++rr) {
        const bf16_t* kb = kbase0 + (size_t)rr * 64 * HD;
        const bf16x8 k00 = *(const bf16x8*)(kb), k01 = *(const bf16x8*)(kb + 32), k10 = *(const bf16x8*)(kb + 4 * HD), k11 = *(const bf16x8*)(kb + 4 * HD + 32);
        const bf16_t* vb = vbase0 + rr * 64;
        bf16x8 vf[4];
#pragma unroll
        for (int db = 0; db < 4; ++db) vf[db] = *(const bf16x8*)(vb + (size_t)db * 16 * MTOT);
        f32x4 s0 = __builtin_amdgcn_mfma_f32_16x16x32_bf16(k00, qr0, zero4, 0, 0, 0); s0 = __builtin_amdgcn_mfma_f32_16x16x32_bf16(k01, qr1, s0, 0, 0, 0);
        f32x4 s1 = __builtin_amdgcn_mfma_f32_16x16x32_bf16(k10, qr0, zero4, 0, 0, 0); s1 = __builtin_amdgcn_mfma_f32_16x16x32_bf16(k11, qr1, s1, 0, 0, 0);
        const int dr = rs + rr - i + 7;
        const LAS float* tb = btab + (h * 15 + dr) * 64 + dcb;
        float pj[8];
#pragma unroll
        for (int j = 0; j < 8; ++j) { const float sv = (j < 4 ? s0[j] : s1[j - 4]) + tb[j]; const float e = __builtin_amdgcn_exp2f(sv); pj[j] = ((vmask >> j) & 1u) ? e : 0.f; lsum += pj[j]; }
        u32x4 pw; pw.x = cvtpk(pj[0], pj[1]); pw.y = cvtpk(pj[2], pj[3]); pw.z = cvtpk(pj[4], pj[5]); pw.w = cvtpk(pj[6], pj[7]);
        const bf16x8 pb = __builtin_bit_cast(bf16x8, pw);
#pragma unroll
        for (int db = 0; db < 4; ++db) o[db] = __builtin_amdgcn_mfma_f32_16x16x32_bf16(vf[db], pb, o[db], 0, 0, 0);
    }
    const bf16_t* kcb0 = KC + ((size_t)bh * CTXL + krow0) * HD + quad * 8;
    const bf16_t* vcb0 = VT + (size_t)(h * HD + q16) * MTOT + MLAT + b * CTXL + 8 * quad;
#pragma unroll
    for (int cb = 0; cb < 8; ++cb) {
        const bf16_t* kb = kcb0 + (size_t)cb * 32 * HD;
        const bf16x8 k00 = *(const bf16x8*)(kb), k01 = *(const bf16x8*)(kb + 32), k10 = *(const bf16x8*)(kb + 4 * HD), k11 = *(const bf16x8*)(kb + 4 * HD + 32);
        const bf16_t* vb = vcb0 + cb * 32;
        bf16x8 vf[4];
#pragma unroll
        for (int db = 0; db < 4; ++db) vf[db] = *(const bf16x8*)(vb + (size_t)db * 16 * MTOT);
        f32x4 s0 = __builtin_amdgcn_mfma_f32_16x16x32_bf16(k00, qp0, zero4, 0, 0, 0); s0 = __builtin_amdgcn_mfma_f32_16x16x32_bf16(k01, qp1, s0, 0, 0, 0);
        f32x4 s1 = __builtin_amdgcn_mfma_f32_16x16x32_bf16(k10, qp0, zero4, 0, 0, 0); s1 = __builtin_amdgcn_mfma_f32_16x16x32_bf16(k11, qp1, s1, 0, 0, 0);
        float pj[8];
#pragma unroll
        for (int j = 0; j < 8; ++j) { pj[j] = __builtin_amdgcn_exp2f((j < 4 ? s0[j] : s1[j - 4]) - B2); lsum += pj[j]; }
        u32x4 pw; pw.x = cvtpk(pj[0], pj[1]); pw.y = cvtpk(pj[2], pj[3]); pw.z = cvtpk(pj[4], pj[5]); pw.w = cvtpk(pj[6], pj[7]);
        const bf16x8 pb = __builtin_bit_cast(bf16x8, pw);
#pragma unroll
        for (int db = 0; db < 4; ++db) o[db] = __builtin_amdgcn_mfma_f32_16x16x32_bf16(vf[db], pb, o[db], 0, 0, 0);
    }
    lsum += __shfl_xor(lsum, 16); lsum += __shfl_xor(lsum, 32);
    const float inv = 1.0f / lsum;
    const size_t tok = (size_t)b * SEQ + i * 64 + qcol;
#pragma unroll
    for (int db = 0; db < 4; ++db) {
        const int d0 = h * HD + 16 * db + 4 * quad;
        const u32x2 zz = *(const u32x2*)(ZA + tok * 512 + d0);
        const float z0 = __builtin_bit_cast(float, zz.x << 16), z1 = __builtin_bit_cast(float, zz.x & 0xffff0000u), z2 = __builtin_bit_cast(float, zz.y << 16), z3 = __builtin_bit_cast(float, zz.y & 0xffff0000u);
        u32x2 w; w.x = cvtpk(o[db][0] * inv * z0, o[db][1] * inv * z1); w.y = cvtpk(o[db][2] * inv * z2, o[db][3] * inv * z3);
        *(u32x2*)(MIX + tok * DM + d0) = w;
    }
}

__device__ __forceinline__ void phase3(const Params& p, LAS unsigned char* lds) {
    const int tid = threadIdx.x, lane = tid & 63, wave = __builtin_amdgcn_readfirstlane(tid >> 6);
    LAS float* btab = (LAS float*)lds;
    const float B2 = *(const float*)(p.ws + WS_BND);
    for (int idx = tid; idx < NH * 15 * 64; idx += NTHREADS) {
        const int c = idx & 63, hd = idx >> 6; const int dc = min(max(c - 16, 0), 30);
        btab[idx] = p.rpb[hd * 31 + dc] * LOG2E - B2;
    }
    __syncthreads();
    const int G = gridDim.x, x = blockIdx.x & 7, lb = blockIdx.x >> 3, nb = G >> 3;
    for (int li = lb; li < 128; li += nb) {
        const int bh = 8 * x + (li >> 4), ipair = li & 15;
        attn_item(p, btab, B2, bh >> 3, bh & 7, 2 * ipair + (wave >> 2), wave & 3, lane);
    }
    const bf16_t* CG = (const bf16_t*)(p.ws + WS_CG); bf16_t* MIX = (bf16_t*)(p.ws + WS_MIX);
    const int g = tid & 127;
    const f32x4 w0 = *(const f32x4*)(p.conv_w + 4 * g), w1 = *(const f32x4*)(p.conv_w + 512 + 4 * g), w2 = *(const f32x4*)(p.conv_w + 1024 + 4 * g), cb = *(const f32x4*)(p.conv_b + 4 * g);
    for (int tok = blockIdx.x * 4 + (tid >> 7); tok < MLAT; tok += G * 4) {
        const int t = tok & (SEQ - 1);
        const u32x4 cur = *(const u32x4*)(CG + (size_t)tok * 1024 + g * 8);
        u32x2 pv = {0u, 0u}, nv = {0u, 0u};
        if (t > 0) pv = *(const u32x2*)(CG + (size_t)(tok - 1) * 1024 + g * 8);
        if (t < SEQ - 1) nv = *(const u32x2*)(CG + (size_t)(tok + 1) * 1024 + g * 8);
#define LO16(u) __builtin_bit_cast(float, (u) << 16)
#define HI16(u) __builtin_bit_cast(float, (u) & 0xffff0000u)
        const f32x4 cp = {LO16(pv.x), HI16(pv.x), LO16(pv.y), HI16(pv.y)};
        const f32x4 cc = {LO16(cur.x), HI16(cur.x), LO16(cur.y), HI16(cur.y)};
        const f32x4 cn = {LO16(nv.x), HI16(nv.x), LO16(nv.y), HI16(nv.y)};
        const f32x4 gz = {LO16(cur.z), HI16(cur.z), LO16(cur.w), HI16(cur.w)};
#undef LO16
#undef HI16
        const f32x4 y = gz * (cb + w0 * cp + w1 * cc + w2 * cn);
        u32x2 w; w.x = cvtpk(y[0], y[1]); w.y = cvtpk(y[2], y[3]);
        *(u32x2*)(MIX + (size_t)tok * DM + 512 + 4 * g) = w;
    }
}

__global__ void __launch_bounds__(NTHREADS, 2) fwd_megakernel(Params p) {
    extern __shared__ __attribute__((aligned(16))) unsigned char lds_raw[];
    LAS unsigned char* lds = (LAS unsigned char*)lds_raw;
    cg::grid_group grid = cg::this_grid();
    const int lo = p.ph_lo, hi = p.ph_hi;
    const int x = blockIdx.x & 7, lb = blockIdx.x >> 3, nb = gridDim.x >> 3;
    EpiCtx E;
    E.QP = (bf16_t*)(p.ws + WS_QP); E.QR = (bf16_t*)(p.ws + WS_QR); E.KR = (bf16_t*)(p.ws + WS_KR); E.KC = (bf16_t*)(p.ws + WS_KC);
    E.VT = (bf16_t*)(p.ws + WS_VT); E.ZA = (bf16_t*)(p.ws + WS_ZA); E.CG = (bf16_t*)(p.ws + WS_CG);
    E.gq = p.q_norm_g; E.gk = p.k_norm_g; E.rope = (const float*)(p.ws + WS_ROPE);
    E.x = p.x; E.gate = (const float*)(p.ws + WS_GATE); E.out = p.out;
#define IN(k) (lo <= (k) && (k) < hi)
#define SEAM(k) do { if (IN(k) && IN((k) + 1)) grid.sync(); } while (0)
    if (IN(0)) phase0(p, lds);
    SEAM(0);
    if (IN(1)) phase1(p, lds);
    SEAM(1);
    if (IN(2)) { SchedP2 S{x, lb, nb, (const char*)(p.ws + WS_XN), (const char*)(p.ws + WS_WT)}; gemm_phase<2>(lds, S, E); }
    SEAM(2);
    if (IN(3)) phase3(p, lds);
    SEAM(3);
    if (IN(4)) { SchedP4 S{x, lb, nb, (const char*)(p.ws + WS_MIX), (const char*)(p.ws + WS_WO)}; gemm_phase<4>(lds, S, E); }
#undef IN
#undef SEAM
}

extern "C" void kernel_launch(void* const* d_in, const int* in_sizes, int n_in, void* d_out, int out_size, void* d_ws, size_t ws_size, hipStream_t stream) {
    static int grid = 0;
    if (grid == 0) {
        int dev = 0, cus = 0, per_cu = 0;
        hipGetDevice(&dev);
        hipDeviceGetAttribute(&cus, hipDeviceAttributeMultiprocessorCount, dev);
        if (hipFuncSetAttribute((const void*)fwd_megakernel, hipFuncAttributeMaxDynamicSharedMemorySize, LDS_BYTES) != hipSuccess) { fprintf(stderr, "hipFuncSetAttribute failed\n"); grid = -1; return; }
        hipOccupancyMaxActiveBlocksPerMultiprocessor(&per_cu, (const void*)fwd_megakernel, NTHREADS, LDS_BYTES);
        if (per_cu < 1) { fprintf(stderr, "occupancy query says %d blocks per CU\n", per_cu); grid = -1; return; }
        grid = cus;
        grid -= grid % 8;
        if (n_in != 14 || ws_size < WS_END || grid < 8) { fprintf(stderr, "unexpected problem geometry\n"); grid = -1; return; }
    }
    if (grid < 0) return;
    Params p{};
    p.x = (const float*)d_in[0]; p.c = (const float*)d_in[1]; p.ctx = (const float*)d_in[2]; p.c_ctx = (const float*)d_in[3];
    p.w_ada = (const float*)d_in[4]; p.b_ada = (const float*)d_in[5]; p.norm_g = (const float*)d_in[6]; p.w_in = (const float*)d_in[7];
    p.q_norm_g = (const float*)d_in[8]; p.k_norm_g = (const float*)d_in[9]; p.rpb = (const float*)d_in[10]; p.conv_w = (const float*)d_in[11];
    p.conv_b = (const float*)d_in[12]; p.w_out = (const float*)d_in[13];
    p.out = (float*)d_out; p.ws = (unsigned char*)d_ws;
#if N_LAUNCH_MODE == 1
    p.ph_lo = 0; p.ph_hi = 5;
    void* args[] = {&p};
    hipError_t e = hipLaunchCooperativeKernel((const void*)fwd_megakernel, dim3(grid), dim3(NTHREADS), args, LDS_BYTES, stream);
    if (e != hipSuccess) fprintf(stderr, "cooperative launch failed: %s (grid %d)\n", hipGetErrorString(e), grid);
#else
    for (int ph = 0; ph < 5; ++ph) {
        p.ph_lo = ph; p.ph_hi = ph + 1;
        hipLaunchKernelGGL(fwd_megakernel, dim3(grid), dim3(NTHREADS), LDS_BYTES, stream, p);
    }
#endif
}
```

```cpp
#include <hip/hip_runtime.h>
#include <hip/hip_cooperative_groups.h>
#include <cstdio>
#include <cstdint>
namespace cg = cooperative_groups;

#ifndef N_LAUNCH_MODE
#define N_LAUNCH_MODE 1
#endif

#ifndef PROBE_REP
#define PROBE_REP -1
#endif

#define LAS __attribute__((address_space(3)))
typedef unsigned short bf16_t;
typedef short bf16x8 __attribute__((ext_vector_type(8)));
typedef float f32x4 __attribute__((ext_vector_type(4)));
typedef float f32x2 __attribute__((ext_vector_type(2)));
typedef unsigned u32x4 __attribute__((ext_vector_type(4)));
typedef unsigned u32x2 __attribute__((ext_vector_type(2)));
typedef __bf16 bf16x2_t __attribute__((ext_vector_type(2)));

constexpr int NBATCH = 8, SEQ = 2048, DM = 1024, CTXL = 256, NH = 8, HD = 64;
constexpr int MLAT = NBATCH * SEQ, MCTX = NBATCH * CTXL, MTOT = MLAT + MCTX;
constexpr int DIN = 4096, NADA = 3072;
constexpr float RMS_EPS = 1e-6f;
constexpr float LOG2E = 1.4426950408889634f;

constexpr size_t MiB = 1u << 20;
constexpr size_t WS_WT = 0;
constexpr size_t WS_WO = 8 * MiB;
constexpr size_t WS_ADAP = 10 * MiB;
constexpr size_t WS_GATE = 11 * MiB;
constexpr size_t WS_ROPE = 11 * MiB + 65536;
constexpr size_t WS_BND = 11 * MiB + 131072;
constexpr size_t WS_BAR = 11 * MiB + 262144;
constexpr size_t BAR_BYTES = 16384;
constexpr int LDS_MISC = 147456 - 64;
constexpr size_t WS_XN = 12 * MiB;
constexpr size_t WS_QP = 48 * MiB;
constexpr size_t WS_QR = 64 * MiB;
constexpr size_t WS_KR = 80 * MiB;
constexpr size_t WS_KC = 96 * MiB;
constexpr size_t WS_VT = 98 * MiB;
constexpr size_t WS_ZA = 116 * MiB;
constexpr size_t WS_CG = 132 * MiB;
constexpr size_t WS_MIX = 164 * MiB;
constexpr size_t WS_END = 196 * MiB;

constexpr int LDS_BYTES = 147456;
constexpr int NTHREADS = 512;

struct Params {
    const float *x, *c, *ctx, *c_ctx, *w_ada, *b_ada, *norm_g, *w_in, *q_norm_g, *k_norm_g, *rpb, *conv_w, *conv_b, *w_out;
    float* out; unsigned char* ws; int ph_lo, ph_hi;
};

__device__ __forceinline__ unsigned cvtpk(float lo, float hi) { f32x2 v = {lo, hi}; bf16x2_t b = __builtin_convertvector(v, bf16x2_t); return __builtin_bit_cast(unsigned, b); }
__device__ __forceinline__ float bf2f(unsigned short h) { return __builtin_bit_cast(float, (unsigned)h << 16); }
__device__ __forceinline__ float silu_f(float v) { return v * __builtin_amdgcn_rcpf(1.0f + __builtin_amdgcn_exp2f(-v * LOG2E)); }
__device__ __forceinline__ float wave_sum(float v) {
#pragma unroll
    for (int o = 1; o < 64; o <<= 1) v += __shfl_xor(v, o);
    return v;
}

constexpr int BM = 256, BK = 64, HALF = 128, HTB = HALF * BK * 2, KDIM = 1024;
constexpr size_t TSTEP = (size_t)BM * KDIM * 2;
__device__ __forceinline__ int lds_byte(int r, int c) { const int st = (r >> 4) * 2 + (c >> 5), rr = r & 15, cc = c & 31, ob = rr * 64 + cc * 2; return st * 1024 + (ob ^ (((ob >> 9) & 1) << 5)); }
__device__ __forceinline__ void stage_rc(int b, int& R, int& C) { const int st = b / 1024, sb = b % 1024, swz = sb ^ (((sb >> 9) & 1) << 5); R = (st >> 1) * 16 + swz / 64; C = (st & 1) * 32 + (swz % 64) / 2; }
__device__ __forceinline__ int perm32(int rho) { const int n = rho >> 4, i = rho & 15; return 8 * (i >> 2) + 4 * n + (i & 3); }

struct Unit { const char* a; const char* b; int kind, pm, pn; };

struct EpiCtx {
    bf16_t *QP, *QR, *KR, *KC, *VT, *ZA, *CG;
    const float *gq, *gk, *rope;
    const float *x, *gate; float* out;
};

template <int PH>
__device__ __forceinline__ void epilogue(const f32x4 (&acc)[2][2][4][2], const Unit& u, int wr, int wc, int fr, int fq, const EpiCtx& E) {
    if constexpr (PH == 4) {
        const int b = (u.pm * BM) >> 11;
        const int c0 = u.pn * BM + wc * 32 + fq * 8;
        f32x4 gv[2][2];
#pragma unroll
        for (int bj = 0; bj < 2; ++bj)
#pragma unroll
            for (int n = 0; n < 2; ++n) gv[bj][n] = *(const f32x4*)(E.gate + b * DM + c0 + bj * HALF + 4 * n);
#pragma unroll
        for (int ai = 0; ai < 2; ++ai)
#pragma unroll
            for (int m = 0; m < 4; ++m) {
                const size_t off = (size_t)(u.pm * BM + ai * HALF + wr * 64 + m * 16 + fr) * DM + c0;
#pragma unroll
                for (int bj = 0; bj < 2; ++bj)
#pragma unroll
                    for (int n = 0; n < 2; ++n) {
                        const f32x4 xv = *(const f32x4*)(E.x + off + bj * HALF + 4 * n);
                        *(f32x4*)(E.out + off + bj * HALF + 4 * n) = xv + gv[bj][n] * acc[ai][bj][m][n];
                    }
            }
    } else {
        const int kind = u.kind;
        if (kind == 0 || kind == 1 || kind == 5) {
            const bool isq = (kind == 0);
            const float* g = isq ? E.gq : E.gk;
            const float qs = isq ? 0.125f * LOG2E : 1.0f;
            const int head = 4 * (u.pn & 1) + wc;
            f32x4 gv[2][2];
#pragma unroll
            for (int bj = 0; bj < 2; ++bj)
#pragma unroll
                for (int n = 0; n < 2; ++n) gv[bj][n] = *(const f32x4*)(g + 32 * bj + 16 * n + 4 * fq);
#pragma unroll
            for (int ai = 0; ai < 2; ++ai)
#pragma unroll
                for (int m = 0; m < 4; ++m) {
                    const int r = u.pm * BM + ai * HALF + wr * 64 + m * 16 + fr;
                    f32x4 v[2][2]; float ss = 0.f;
#pragma unroll
                    for (int bj = 0; bj < 2; ++bj)
#pragma unroll
                        for (int n = 0; n < 2; ++n) { v[bj][n] = acc[ai][bj][m][n]; const f32x4 t = v[bj][n] * v[bj][n]; ss += (t[0] + t[1]) + (t[2] + t[3]); }
                    ss += __shfl_xor(ss, 16); ss += __shfl_xor(ss, 32);
                    const float rinv = __builtin_amdgcn_rsqf(ss * (1.0f / 64.0f) + RMS_EPS) * qs;
#pragma unroll
                    for (int bj = 0; bj < 2; ++bj)
#pragma unroll
                        for (int n = 0; n < 2; ++n) v[bj][n] = v[bj][n] * rinv * gv[bj][n];
                    if (kind == 5) {
                        const int rc = r - MLAT, b = rc >> 8, l = rc & 255;
                        bf16_t* dst = E.KC + ((size_t)((b * NH + head) * CTXL + l)) * HD + fq * 16;
#pragma unroll
                        for (int bj = 0; bj < 2; ++bj) { u32x4 w; w.x = cvtpk(v[bj][0][0], v[bj][0][1]); w.y = cvtpk(v[bj][0][2], v[bj][0][3]); w.z = cvtpk(v[bj][1][0], v[bj][1][1]); w.w = cvtpk(v[bj][1][2], v[bj][1][3]); *(u32x4*)(dst + bj * 8) = w; }
                    } else {
                        const int b = r >> 11, t = r & 2047, grow = t >> 6, gcol = t & 63;
                        const size_t rowoff = ((size_t)((b * NH + head) * SEQ + t)) * HD + fq * 16;
                        if (isq) {
                            bf16_t* dst = E.QP + rowoff;
#pragma unroll
                            for (int bj = 0; bj < 2; ++bj) { u32x4 w; w.x = cvtpk(v[bj][0][0], v[bj][0][1]); w.y = cvtpk(v[bj][0][2], v[bj][0][3]); w.z = cvtpk(v[bj][1][0], v[bj][1][1]); w.w = cvtpk(v[bj][1][2], v[bj][1][3]); *(u32x4*)(dst + bj * 8) = w; }
                        }
                        bf16_t* dst = (isq ? E.QR : E.KR) + rowoff;
#pragma unroll
                        for (int bj = 0; bj < 2; ++bj) {
                            const int pos = bj ? gcol : grow;
                            const f32x4 cs = *(const f32x4*)(E.rope + pos * 16 + 4 * fq), sn = *(const f32x4*)(E.rope + 1024 + pos * 16 + 4 * fq);
                            const f32x4 o0 = v[bj][0] * cs - v[bj][1] * sn, o1 = v[bj][1] * cs + v[bj][0] * sn;
                            u32x4 w; w.x = cvtpk(o0[0], o0[1]); w.y = cvtpk(o0[2], o0[3]); w.z = cvtpk(o1[0], o1[1]); w.w = cvtpk(o1[2], o1[3]);
                            *(u32x4*)(dst + bj * 8) = w;
                        }
                    }
                }
        } else if (kind == 2) {
            const int c0 = (u.pn - 6) * BM + wc * 32 + fq * 8;
#pragma unroll
            for (int ai = 0; ai < 2; ++ai)
#pragma unroll
                for (int m = 0; m < 4; ++m) {
                    bf16_t* dst = E.ZA + (size_t)(u.pm * BM + ai * HALF + wr * 64 + m * 16 + fr) * 512 + c0;
#pragma unroll
                    for (int bj = 0; bj < 2; ++bj) {
                        const f32x4 a0 = acc[ai][bj][m][0], a1 = acc[ai][bj][m][1];
                        u32x4 w; w.x = cvtpk(silu_f(a0[0]), silu_f(a0[1])); w.y = cvtpk(silu_f(a0[2]), silu_f(a0[3])); w.z = cvtpk(silu_f(a1[0]), silu_f(a1[1])); w.w = cvtpk(silu_f(a1[2]), silu_f(a1[3]));
                        *(u32x4*)(dst + bj * HALF) = w;
                    }
                }
        } else if (kind == 3) {
            const int ch0 = (u.pn - 8) * 64 + wc * 16 + fq * 4;
#pragma unroll
            for (int ai = 0; ai < 2; ++ai)
#pragma unroll
                for (int m = 0; m < 4; ++m) {
                    const f32x4 uu = acc[ai][0][m][0], bg = acc[ai][0][m][1], cgv = acc[ai][1][m][0], zc = acc[ai][1][m][1];
                    const f32x4 cu = cgv * uu;
                    f32x4 gz;
#pragma unroll
                    for (int j = 0; j < 4; ++j) gz[j] = bg[j] * silu_f(zc[j]);
                    u32x4 w; w.x = cvtpk(cu[0], cu[1]); w.y = cvtpk(cu[2], cu[3]); w.z = cvtpk(gz[0], gz[1]); w.w = cvtpk(gz[2], gz[3]);
                    *(u32x4*)(E.CG + (size_t)(u.pm * BM + ai * HALF + wr * 64 + m * 16 + fr) * 1024 + ch0 * 2) = w;
                }
        } else {
            const int c0 = u.pn * BM + wc * 32 + fq * 8;
#pragma unroll
            for (int ai = 0; ai < 2; ++ai)
#pragma unroll
                for (int m = 0; m < 4; ++m) {
                    bf16_t* dst = E.VT + (size_t)(u.pm * BM + ai * HALF + wr * 64 + m * 16 + fr) * MTOT + c0;
#pragma unroll
                    for (int bj = 0; bj < 2; ++bj) {
                        const f32x4 a0 = acc[ai][bj][m][0], a1 = acc[ai][bj][m][1];
                        u32x4 w; w.x = cvtpk(a0[0], a0[1]); w.y = cvtpk(a0[2], a0[3]); w.z = cvtpk(a1[0], a1[1]); w.w = cvtpk(a1[2], a1[3]);
                        *(u32x4*)(dst + bj * HALF) = w;
                    }
                }
        }
    }
}

struct SchedP2 {
    int x, lb, nb; const char* XN; const char* WT;
    __device__ __forceinline__ bool next(int i, Unit& u) const {
        const int uu = lb + i * nb; if (uu >= 132) return false;
        if (uu < 112) {
            const int pi = uu >> 3, pm = 8 * x + (uu & 7), pn = pi < 4 ? pi : pi + 2;
            u.kind = pn < 2 ? 0 : (pn < 4 ? 1 : (pn < 8 ? 2 : 3)); u.pm = pm; u.pn = pn; u.a = XN + (size_t)pm * TSTEP; u.b = WT + (size_t)pn * TSTEP;
        } else if (uu < 130) {
            const int v = uu - 112, pnp = 9 * x + v % 9, pmp = v / 9;
            u.kind = 4; u.pm = pmp; u.pn = pnp; u.a = WT + (size_t)(4 + pmp) * TSTEP; u.b = XN + (size_t)pnp * TSTEP;
        } else {
            u.kind = 5; u.pm = 64 + x; u.pn = 2 + (uu - 130); u.a = XN + (size_t)u.pm * TSTEP; u.b = WT + (size_t)u.pn * TSTEP;
        }
        return true;
    }
};
struct SchedP4 {
    int x, lb, nb; const char* MIX; const char* WO;
    __device__ __forceinline__ bool next(int i, Unit& u) const {
        const int uu = lb + i * nb; if (uu >= 32) return false;
        u.kind = 6; u.pm = 8 * x + (uu & 7); u.pn = uu >> 3; u.a = MIX + (size_t)u.pm * TSTEP; u.b = WO + (size_t)u.pn * TSTEP; return true;
    }
};

template <int PH, class Sched>
__device__ __forceinline__ void gemm_phase(LAS unsigned char* lds, const Sched& S, const EpiCtx& E) {
    const int tid = threadIdx.x, wid = __builtin_amdgcn_readfirstlane(tid >> 6), lane = tid & 63, wr = wid >> 2, wc = wid & 3, fr = lane & 15, fq = lane >> 4;
    constexpr int K = KDIM, nt = K / BK;
    unsigned voffA[2], voffB[2];
#pragma unroll
    for (int i = 0; i < 2; ++i) { int R, C; stage_rc(tid * 16 + i * 8192, R, C); const int Rb = (R & ~31) + perm32(R & 31);
        voffA[i] = (unsigned)(R * K + C) * 2u; voffB[i] = (unsigned)(Rb * K + C) * 2u; }
    const size_t kstep = (size_t)(BK * 2);
    const size_t hstep = (size_t)HALF * K * 2;
    const unsigned ldsw = (unsigned)wid * 1024u;
    const int aoff = lds_byte(wr * 64 + fr, fq * 8), boff = lds_byte(wc * 32 + fr, fq * 8);
#define PG8_SA(b, h) (((b) * 2 + (h)) * HTB)
#define PG8_SB(b, h) ((4 + (b) * 2 + (h)) * HTB)
#define PG8_STAGE(bufoff, gbase, voff) do { _Pragma("unroll") for (int _i = 0; _i < 2; ++_i) \
        __builtin_amdgcn_global_load_lds((const unsigned*)((const char*)(gbase) + (voff)[_i]), (LAS unsigned*)(lds + (bufoff) + ldsw + _i * 8192), 16, 0, 0); } while (0)
#define PG8_LDA(dst, b, h) do { _Pragma("unroll") for (int m = 0; m < 4; ++m) _Pragma("unroll") for (int k = 0; k < 2; ++k) dst[m][k] = *(const LAS bf16x8*)(lds + PG8_SA(b, h) + aoff + m * 2048 + k * 1024); } while (0)
#define PG8_LDB(dst, b, h) do { _Pragma("unroll") for (int n = 0; n < 2; ++n) _Pragma("unroll") for (int k = 0; k < 2; ++k) dst[n][k] = *(const LAS bf16x8*)(lds + PG8_SB(b, h) + boff + n * 2048 + k * 1024); } while (0)
#define PG8_MMA(ai, bj, At, Bt) do { __builtin_amdgcn_s_setprio(1); _Pragma("unroll") for (int m = 0; m < 4; ++m) _Pragma("unroll") for (int n = 0; n < 2; ++n) _Pragma("unroll") for (int k = 0; k < 2; ++k) \
        acc[ai][bj][m][n] = __builtin_amdgcn_mfma_f32_16x16x32_bf16(Bt[n][k], At[m][k], acc[ai][bj][m][n], 0, 0, 0); __builtin_amdgcn_s_setprio(0); } while (0)
#define PG8_WAIT_V(n) asm volatile("s_waitcnt vmcnt(" #n ")" ::: "memory")
#define PG8_WAIT_L(n) asm volatile("s_waitcnt lgkmcnt(" #n ")" ::: "memory")
#define PG8_BAR __builtin_amdgcn_s_barrier()
#define PG8_SCHED __builtin_amdgcn_sched_barrier(0)
    Unit cur, nxt; int ui = 0;
    if (!S.next(0, cur)) return;
    f32x4 acc[2][2][4][2];
#pragma unroll
    for (int a = 0; a < 2; ++a)
#pragma unroll
        for (int b = 0; b < 2; ++b)
#pragma unroll
            for (int m = 0; m < 4; ++m)
#pragma unroll
                for (int n = 0; n < 2; ++n) acc[a][b][m][n] = (f32x4){0.f, 0.f, 0.f, 0.f};
    bf16x8 At[4][2], B0[2][2], B1[2][2];
    const char* cA = cur.a; const char* cB = cur.b;
    PG8_STAGE(PG8_SB(0, 0), cB, voffB); PG8_STAGE(PG8_SB(0, 1), cB + hstep, voffB); PG8_STAGE(PG8_SA(0, 0), cA, voffA); PG8_STAGE(PG8_SA(0, 1), cA + hstep, voffA);
    if (wr == 1) PG8_BAR;
    PG8_WAIT_V(2); PG8_BAR;
    PG8_STAGE(PG8_SB(1, 0), cB + kstep, voffB); PG8_STAGE(PG8_SA(1, 0), cA + kstep, voffA); PG8_STAGE(PG8_SB(1, 1), cB + hstep + kstep, voffB);
    PG8_WAIT_V(6); PG8_BAR;
    for (;;) {
        const bool has_next = S.next(ui + 1, nxt);
        const char* nA = has_next ? nxt.a : cA; const char* nB = has_next ? nxt.b : cB;
        for (int t = 0; t < nt; t += 2) {
            const bool last = (t == nt - 2);
            const char* a1 = cA + (size_t)(t + 1) * kstep;
            const char* a2 = last ? nA : cA + (size_t)(t + 2) * kstep; const char* b2 = last ? nB : cB + (size_t)(t + 2) * kstep;
            const char* a3 = a2 + kstep; const char* b3 = b2 + kstep;
            PG8_LDB(B0, 0, 0); PG8_LDB(B1, 0, 1); PG8_SCHED; PG8_LDA(At, 0, 0); PG8_STAGE(PG8_SA(1, 1), a1 + hstep, voffA);
            PG8_WAIT_V(8); PG8_WAIT_L(0); PG8_BAR; PG8_MMA(0, 0, At, B0); PG8_MMA(0, 1, At, B1); PG8_BAR; PG8_SCHED;
            PG8_LDA(At, 0, 1); PG8_STAGE(PG8_SB(0, 0), b2, voffB); PG8_STAGE(PG8_SB(0, 1), b2 + hstep, voffB); PG8_STAGE(PG8_SA(0, 0), a2, voffA);
            PG8_WAIT_V(8); PG8_WAIT_L(0); PG8_BAR; PG8_MMA(1, 0, At, B0); PG8_MMA(1, 1, At, B1); PG8_BAR; PG8_SCHED;
            PG8_LDB(B0, 1, 0); PG8_LDB(B1, 1, 1); PG8_SCHED; PG8_LDA(At, 1, 0); PG8_STAGE(PG8_SA(0, 1), a2 + hstep, voffA);
            PG8_WAIT_V(8); PG8_WAIT_L(0); PG8_BAR; PG8_MMA(0, 0, At, B0); PG8_MMA(0, 1, At, B1); PG8_BAR; PG8_SCHED;
            PG8_LDA(At, 1, 1); PG8_STAGE(PG8_SB(1, 0), b3, voffB); PG8_STAGE(PG8_SB(1, 1), b3 + hstep, voffB); PG8_STAGE(PG8_SA(1, 0), a3, voffA);
            PG8_WAIT_V(8); PG8_WAIT_L(0); PG8_BAR; PG8_MMA(1, 0, At, B0); PG8_MMA(1, 1, At, B1); PG8_BAR; PG8_SCHED;
        }
        if (wr == 0) PG8_BAR;
        epilogue<PH>(acc, cur, wr, wc, fr, fq, E);
        if (!has_next) break;
#pragma unroll
        for (int a = 0; a < 2; ++a)
#pragma unroll
            for (int b = 0; b < 2; ++b)
#pragma unroll
                for (int m = 0; m < 4; ++m)
#pragma unroll
                    for (int n = 0; n < 2; ++n) acc[a][b][m][n] = (f32x4){0.f, 0.f, 0.f, 0.f};
        cur = nxt; cA = nA; cB = nB; ++ui;
        if (wr == 1) PG8_BAR;
    }
    PG8_WAIT_V(0);
    PG8_BAR;
#undef PG8_SA
#undef PG8_SB
#undef PG8_STAGE
#undef PG8_LDA
#undef PG8_LDB
#undef PG8_MMA
#undef PG8_WAIT_V
#undef PG8_WAIT_L
#undef PG8_BAR
#undef PG8_SCHED
}

__device__ __forceinline__ int wt_dst_row(int c) {
    if (c < 1024) {
        const int base = c & ~511, local = c & 511, head = local >> 6, d = local & 63;
        const int pnl = head >> 2, wc = head & 3, bj = d >> 5, n = (d >> 4) & 1, f = d & 15, fq = f >> 2, j = f & 3;
        return base + pnl * 256 + 128 * bj + 32 * wc + 8 * fq + 4 * n + j;
    } else if (c < 2048) {
        return c;
    } else {
        const int type = (c - 2048) >> 9, ch = (c - 2048) & 511, ct = ch >> 6, chl = ch & 63;
        const int wc = chl >> 4, fq = (chl >> 2) & 3, j = chl & 3, bj = type >> 1, n = type & 1;
        return 2048 + ct * 256 + 128 * bj + 32 * wc + 8 * fq + 4 * n + j;
    }
}
template <bool PERMUTE>
__device__ __forceinline__ void p0_transpose_item(const float* W, int N, bf16_t* WT, LAS float* scr, int item, int lane) {
    const int nblk = N / 32, kb = item / nblk, nb = item % nblk, k0 = 64 * kb, n0 = 32 * nb;
#pragma unroll 8
    for (int i = 0; i < 32; ++i) { const int kk = 2 * i + (lane >> 5); scr[kk * 33 + (lane & 31)] = W[(size_t)(k0 + kk) * N + n0 + (lane & 31)]; }
    asm volatile("s_waitcnt lgkmcnt(0)" ::: "memory");
    const int c = lane & 7;
#pragma unroll
    for (int j = 0; j < 4; ++j) { const int n = (lane >> 3) + 8 * j; const LAS float* s = scr + (8 * c) * 33 + n;
        u32x4 o; o.x = cvtpk(s[0 * 33], s[1 * 33]); o.y = cvtpk(s[2 * 33], s[3 * 33]); o.z = cvtpk(s[4 * 33], s[5 * 33]); o.w = cvtpk(s[6 * 33], s[7 * 33]);
        const int drow = PERMUTE ? wt_dst_row(n0 + n) : (n0 + n);
        *(u32x4*)(WT + (size_t)drow * KDIM + k0 + 8 * c) = o; }
    asm volatile("s_waitcnt lgkmcnt(0)" ::: "memory");
}

__device__ __forceinline__ void phase0(const Params& p, LAS unsigned char* lds) {
    const int tid = threadIdx.x, lane = tid & 63, wave = __builtin_amdgcn_readfirstlane(tid >> 6);
    const int G = gridDim.x;
    LAS float* sc = (LAS float*)lds;
    LAS float* scr = (LAS float*)(lds + 40960 + wave * 8704);
    for (int idx = tid; idx < 9 * 1024; idx += NTHREADS) { const float v = idx < 8192 ? p.c[idx] : p.c_ctx[idx - 8192]; sc[idx] = v * (1.0f / (1.0f + __expf(-v))); }
    __syncthreads();
    bf16_t* WT = (bf16_t*)(p.ws + WS_WT); bf16_t* WO = (bf16_t*)(p.ws + WS_WO);
    float* ADAP = (float*)(p.ws + WS_ADAP);
    const int gw = wave * G + blockIdx.x, NGW = G * 8;
    constexpr int N_ADA = 768, N_TIN = (KDIM / 64) * (DIN / 32), N_TOUT = (KDIM / 64) * (DM / 32);
    for (int it = gw; it < N_ADA + N_TIN + N_TOUT; it += NGW) {
        if (it < N_ADA) {
            const int cgp = it % 96, kc = it / 96, col = cgp * 32 + (lane & 31), k0 = kc * 128 + (lane >> 5) * 64;
            float a[9];
#pragma unroll
            for (int r = 0; r < 9; ++r) a[r] = 0.f;
#pragma unroll 8
            for (int kk = 0; kk < 64; ++kk) {
                const float w = p.w_ada[(size_t)(k0 + kk) * NADA + col];
#pragma unroll
                for (int r = 0; r < 9; ++r) a[r] += sc[r * 1024 + k0 + kk] * w;
            }
#pragma unroll
            for (int r = 0; r < 9; ++r) { a[r] += __shfl_xor(a[r], 32); if (lane < 32) ADAP[(size_t)(kc * 9 + r) * NADA + col] = a[r]; }
        } else if (it < N_ADA + N_TIN) {
            p0_transpose_item<true>(p.w_in, DIN, WT, scr, it - N_ADA, lane);
        } else {
            p0_transpose_item<false>(p.w_out, DM, WO, scr, it - N_ADA - N_TIN, lane);
        }
    }
    if (blockIdx.x == 0) {
        float* rope = (float*)(p.ws + WS_ROPE);
        if (tid < 16) {
            double inv = 1.0; for (int i = 0; i < tid; ++i) inv *= 0.5623413251903491;
            const double a = (double)(float)inv;
            double s = 0.0, c = 0.0, term = 1.0;
            for (int n = 0; n < 24; ++n) { if ((n & 1) == 0) c += ((n & 2) ? -term : term); else s += ((n & 2) ? -term : term); term *= a / (double)(n + 1); }
            double cp = 1.0, sp = 0.0;
            for (int pos = 0; pos < 64; ++pos) { rope[pos * 16 + tid] = (float)cp; rope[1024 + pos * 16 + tid] = (float)sp; const double cn = cp * c - sp * s, sn = sp * c + cp * s; cp = cn; sp = sn; }
        }
        if (wave == 1) {
            float mq = fabsf(p.q_norm_g[lane]), mk = fabsf(p.k_norm_g[lane]), mr = 0.f;
            for (int i = lane; i < NH * 15 * 31; i += 64) mr = fmaxf(mr, fabsf(p.rpb[i]));
#pragma unroll
            for (int o = 1; o < 64; o <<= 1) { mq = fmaxf(mq, __shfl_xor(mq, o)); mk = fmaxf(mk, __shfl_xor(mk, o)); mr = fmaxf(mr, __shfl_xor(mr, o)); }
            if (lane == 0) *(float*)(p.ws + WS_BND) = (8.0f * mq * mk + mr) * LOG2E;
        }
    }
}

__device__ __forceinline__ void phase1(const Params& p, LAS unsigned char* lds) {
    const int tid = threadIdx.x, lane = tid & 63, wave = __builtin_amdgcn_readfirstlane(tid >> 6);
    LAS float* mult = (LAS float*)lds; LAS float* shf = (LAS float*)(lds + 4096);
    const float* ADAP = (const float*)(p.ws + WS_ADAP);
    bf16_t* XN = (bf16_t*)(p.ws + WS_XN); float* GATE = (float*)(p.ws + WS_GATE);
    for (int chunk = blockIdx.x; chunk < 288; chunk += gridDim.x) {
        const bool lat = chunk < 256; const int ci = lat ? (chunk >> 5) : 8;
        __syncthreads();
        for (int k = tid; k < 1024; k += NTHREADS) {
            float sh = p.b_ada[k], scl = p.b_ada[1024 + k];
#pragma unroll
            for (int kc = 0; kc < 8; ++kc) { sh += ADAP[(size_t)(kc * 9 + ci) * NADA + k]; scl += ADAP[(size_t)(kc * 9 + ci) * NADA + 1024 + k]; }
            mult[k] = p.norm_g[k] * (1.0f + scl); shf[k] = sh;
            if (lat && (chunk & 31) == 0) {
                float gt = p.b_ada[2048 + k];
#pragma unroll
                for (int kc = 0; kc < 8; ++kc) gt += ADAP[(size_t)(kc * 9 + ci) * NADA + 2048 + k];
                GATE[ci * DM + k] = gt;
            }
        }
        __syncthreads();
        const float* src = lat ? p.x + (size_t)chunk * 64 * DM : p.ctx + (size_t)(chunk - 256) * 64 * DM;
        bf16_t* dst = XN + (size_t)chunk * 64 * DM;
        for (int rr = wave; rr < 64; rr += 8) {
            const f32x4* xr = (const f32x4*)(src + (size_t)rr * DM) + lane;
            f32x4 v[4]; float s = 0.f;
#pragma unroll
            for (int j = 0; j < 4; ++j) { v[j] = xr[64 * j]; const f32x4 t = v[j] * v[j]; s += (t[0] + t[1]) + (t[2] + t[3]); }
            const float rinv = __builtin_amdgcn_rsqf(wave_sum(s) * (1.0f / DM) + RMS_EPS);
            u32x2* o8 = (u32x2*)(dst + (size_t)rr * DM) + lane;
#pragma unroll
            for (int j = 0; j < 4; ++j) {
                const f32x4 mu = *(const LAS f32x4*)(mult + 4 * lane + 256 * j), sv = *(const LAS f32x4*)(shf + 4 * lane + 256 * j);
                const f32x4 h = v[j] * rinv * mu + sv;
                u32x2 w; w.x = cvtpk(h[0], h[1]); w.y = cvtpk(h[2], h[3]); o8[64 * j] = w;
            }
        }
    }
}

constexpr int A_CH = 13, A_NS = 6, A_D = 5, A_RING = 32768, A_SLOT = 16384;
__device__ __forceinline__ int swz_k(int key) { return ((key >> 1) & 1) * 2 + ((key >> 3) & 1) * 4; }
__device__ __forceinline__ int swz_v(int d) { return ((d >> 1) & 1) * 2 + ((d >> 2) & 1) * 4; }

__device__ __forceinline__ void glds16(const void* gsrc, unsigned lds_dst) { unsigned keep;
    asm volatile("s_mov_b32 %0, m0\n\ts_mov_b32 m0, %2\n\ts_nop 0\n\tglobal_load_lds_dwordx4 %1, off\n\ts_mov_b32 m0, %0" : "=&s"(keep) : "v"(gsrc), "s"(lds_dst) : "memory"); }

template <bool LAT>
__device__ __forceinline__ void att_blk(const LAS unsigned char* kc, unsigned ko0, unsigned ko1, const LAS unsigned char* vc, unsigned vo,
                                        const bf16x8 q0, const bf16x8 q1, const LAS float* tb, float B2, unsigned vmask, f32x4 (&o)[4], float& lsum) {
    const bf16x8 k00 = *(const LAS bf16x8*)(kc + ko0), k01 = *(const LAS bf16x8*)(kc + ko1), k10 = *(const LAS bf16x8*)(kc + ko0 + 512), k11 = *(const LAS bf16x8*)(kc + ko1 + 512);
    bf16x8 vf[4];
#pragma unroll
    for (int db = 0; db < 4; ++db) vf[db] = *(const LAS bf16x8*)(vc + vo + db * 2048);
    const f32x4 zero4 = {0.f, 0.f, 0.f, 0.f};
    f32x4 s0 = __builtin_amdgcn_mfma_f32_16x16x32_bf16(k00, q0, zero4, 0, 0, 0); s0 = __builtin_amdgcn_mfma_f32_16x16x32_bf16(k01, q1, s0, 0, 0, 0);
    f32x4 s1 = __builtin_amdgcn_mfma_f32_16x16x32_bf16(k10, q0, zero4, 0, 0, 0); s1 = __builtin_amdgcn_mfma_f32_16x16x32_bf16(k11, q1, s1, 0, 0, 0);
    float pj[8];
#pragma unroll
    for (int j = 0; j < 8; ++j) {
        const float sv = (j < 4 ? s0[j] : s1[j - 4]);
        if (LAT) { const float e = __builtin_amdgcn_exp2f(sv + tb[j]); pj[j] = ((vmask >> j) & 1u) ? e : 0.f; }
        else pj[j] = __builtin_amdgcn_exp2f(sv - B2);
        lsum += pj[j];
    }
    u32x4 pw; pw.x = cvtpk(pj[0], pj[1]); pw.y = cvtpk(pj[2], pj[3]); pw.z = cvtpk(pj[4], pj[5]); pw.w = cvtpk(pj[6], pj[7]);
    const bf16x8 pb = __builtin_bit_cast(bf16x8, pw);
#pragma unroll
    for (int db = 0; db < 4; ++db) o[db] = __builtin_amdgcn_mfma_f32_16x16x32_bf16(vf[db], pb, o[db], 0, 0, 0);
}

__device__ __forceinline__ void phase3(const Params& p, LAS unsigned char* lds) {
    const int tid = threadIdx.x, lane = tid & 63, wave = __builtin_amdgcn_readfirstlane(tid >> 6);
    LAS float* btab = (LAS float*)lds;
    const float B2 = *(const float*)(p.ws + WS_BND);
    for (int idx = tid; idx < NH * 15 * 64; idx += NTHREADS) {
        const int c = idx & 63, hd = idx >> 6; const int dc = min(max(c - 16, 0), 30);
        btab[idx] = p.rpb[hd * 31 + dc] * LOG2E - B2;
    }
    __syncthreads();
    const int G = gridDim.x, x = blockIdx.x & 7, lb = blockIdx.x >> 3, nb = G >> 3;
    const bf16_t* QP = (const bf16_t*)(p.ws + WS_QP); const bf16_t* QR = (const bf16_t*)(p.ws + WS_QR);
    const bf16_t* KR = (const bf16_t*)(p.ws + WS_KR); const bf16_t* KC = (const bf16_t*)(p.ws + WS_KC);
    const bf16_t* VT = (const bf16_t*)(p.ws + WS_VT); const bf16_t* ZA = (const bf16_t*)(p.ws + WS_ZA);
    bf16_t* MIXo = (bf16_t*)(p.ws + WS_MIX);
    const unsigned lds0 = (unsigned)(size_t)lds;
    const int n_items = lb < 128 ? (128 - lb + nb - 1) / nb : 0;
    const int total = n_items * A_CH;
    const int ioff = wave >> 2, qc = wave & 3;
    const int q16 = lane & 15, quad = lane >> 4;
    const int qcol = qc * 16 + q16;
    const int cs = (qc == 0) ? 0 : (qc == 1) ? 8 : (qc == 2) ? 24 : 32;
    const int lo = min(max(qcol - 8, 0), 48);
    const int kcol0 = cs + 8 * quad;
    const int dcb = kcol0 - qcol + 15 + 16;
    unsigned vmask = 0;
#pragma unroll
    for (int j = 0; j < 8; ++j) { const int kc = kcol0 + j; if (kc >= lo && kc < lo + 16) vmask |= (1u << j); }
    const int keyl = cs + 8 * (q16 >> 2) + (q16 & 3), keyc = 8 * (q16 >> 2) + (q16 & 3);
    const unsigned ak0 = keyl * 128 + ((quad ^ swz_k(keyl)) * 16), ak1 = keyl * 128 + (((4 + quad) ^ swz_k(keyl)) * 16);
    const unsigned ck0 = keyc * 128 + ((quad ^ swz_k(keyc)) * 16), ck1 = keyc * 128 + (((4 + quad) ^ swz_k(keyc)) * 16);
    const unsigned av = q16 * 128 + ((((cs >> 3) + quad) ^ swz_v(q16)) * 16);
    const unsigned cv0 = q16 * 128 + ((quad ^ swz_v(q16)) * 16), cv1 = q16 * 128 + (((4 + quad) ^ swz_v(q16)) * 16);
    const int drow = wave * 8 + (lane >> 3), dsl = lane & 7;
    const size_t ksrc_off = (size_t)drow * HD + ((dsl ^ swz_k(drow)) * 8);
    const size_t vsrc_off = (size_t)drow * MTOT + ((dsl ^ swz_v(drow)) * 8);
#define A_ISSUE(seq_) do { const int _n = (seq_) / A_CH, _cj = (seq_) - _n * A_CH, _li = lb + _n * nb, _bh = 8 * x + (_li >> 4), _i0 = 2 * (_li & 15); \
        const int _b = _bh >> 3, _h = _bh & 7, _R0 = min(max(_i0 - 4, 0), 24); const int _slot = (seq_) % A_NS; \
        const bf16_t* _ks; const bf16_t* _vs; \
        if (_cj < 9) { const int _r = min(_R0 + _cj, 31); _ks = KR + ((size_t)_bh * SEQ + _r * 64) * HD + ksrc_off; _vs = VT + (size_t)(_h * HD) * MTOT + _b * SEQ + _r * 64 + vsrc_off; } \
        else { const int _c = _cj - 9; _ks = KC + ((size_t)_bh * CTXL + _c * 64) * HD + ksrc_off; _vs = VT + (size_t)(_h * HD) * MTOT + MLAT + _b * CTXL + _c * 64 + vsrc_off; } \
        glds16(_ks, (unsigned)__builtin_amdgcn_readfirstlane((int)(lds0 + A_RING + _slot * A_SLOT + wave * 1024))); \
        glds16(_vs, (unsigned)__builtin_amdgcn_readfirstlane((int)(lds0 + A_RING + _slot * A_SLOT + 8192 + wave * 1024))); } while (0)
#define A_LOADQ(n_) do { const int _li = lb + (n_) * nb, _bh = 8 * x + (_li >> 4), _i = 2 * (_li & 15) + ioff; \
        const size_t _qo = ((size_t)_bh * SEQ + _i * 64 + qcol) * HD + quad * 8; \
        qr0 = *(const bf16x8*)(QR + _qo); qr1 = *(const bf16x8*)(QR + _qo + 32); qp0 = *(const bf16x8*)(QP + _qo); qp1 = *(const bf16x8*)(QP + _qo + 32); } while (0)
    bf16x8 qr0, qr1, qp0, qp1;
    if (n_items > 0) A_LOADQ(0);
    for (int s = 0; s < A_D && s < total; ++s) A_ISSUE(s);
    f32x4 o[4]; float lsum = 0.f; u32x2 zz[4];
#pragma unroll
    for (int db = 0; db < 4; ++db) { o[db] = (f32x4){0.f, 0.f, 0.f, 0.f}; zz[db] = (u32x2){0u, 0u}; }
    int n = 0, cj = 0;
    for (int seq = 0; seq < total; ++seq) {
        const int rem = total - 1 - seq;
        if (rem >= 4) asm volatile("s_waitcnt vmcnt(8)" ::: "memory");
        else if (rem == 3) asm volatile("s_waitcnt vmcnt(6)" ::: "memory");
        else if (rem == 2) asm volatile("s_waitcnt vmcnt(4)" ::: "memory");
        else if (rem == 1) asm volatile("s_waitcnt vmcnt(2)" ::: "memory");
        else asm volatile("s_waitcnt vmcnt(0)" ::: "memory");
        __builtin_amdgcn_s_barrier();
        asm volatile("" ::: "memory");
        if (seq + A_D < total) A_ISSUE(seq + A_D);
        const int li = lb + n * nb, bh = 8 * x + (li >> 4), i0 = 2 * (li & 15), i = i0 + ioff, b = bh >> 3, h = bh & 7;
        const LAS unsigned char* kc = lds + A_RING + (seq % A_NS) * A_SLOT; const LAS unsigned char* vc = kc + 8192;
        if (cj < 9) {
            const int R0 = min(max(i0 - 4, 0), 24), rowu = R0 + cj, rsw = min(max(i - 4, 0), 24);
            if (rowu >= rsw && rowu < rsw + 8) {
                const int dr = rowu - i + 7;
                att_blk<true>(kc, ak0, ak1, vc, av, qr0, qr1, btab + (h * 15 + dr) * 64 + dcb, B2, vmask, o, lsum);
            }
        } else {
            if (cj == 9) {
                const size_t tok = (size_t)b * SEQ + i * 64 + qcol;
#pragma unroll
                for (int db = 0; db < 4; ++db) zz[db] = *(const u32x2*)(ZA + tok * 512 + h * HD + 16 * db + 4 * quad);
            }
            att_blk<false>(kc, ck0, ck1, vc, cv0, qp0, qp1, nullptr, B2, 0u, o, lsum);
            att_blk<false>(kc + 4096, ck0, ck1, vc, cv1, qp0, qp1, nullptr, B2, 0u, o, lsum);
        }
        if (++cj == A_CH) {
            lsum += __shfl_xor(lsum, 16); lsum += __shfl_xor(lsum, 32);
            const float inv = 1.0f / lsum;
            const size_t tok = (size_t)b * SEQ + i * 64 + qcol;
#pragma unroll
            for (int db = 0; db < 4; ++db) {
                const float z0 = __builtin_bit_cast(float, zz[db].x << 16), z1 = __builtin_bit_cast(float, zz[db].x & 0xffff0000u), z2 = __builtin_bit_cast(float, zz[db].y << 16), z3 = __builtin_bit_cast(float, zz[db].y & 0xffff0000u);
                u32x2 w; w.x = cvtpk(o[db][0] * inv * z0, o[db][1] * inv * z1); w.y = cvtpk(o[db][2] * inv * z2, o[db][3] * inv * z3);
                *(u32x2*)(MIXo + tok * DM + h * HD + 16 * db + 4 * quad) = w;
                o[db] = (f32x4){0.f, 0.f, 0.f, 0.f};
            }
            lsum = 0.f; cj = 0; ++n;
            if (n < n_items) A_LOADQ(n);
        }
    }
#undef A_ISSUE
#undef A_LOADQ
    __syncthreads();
}
__device__ __forceinline__ void phase3_conv(const Params& p) {
    const int tid = threadIdx.x, G = gridDim.x;
    const bf16_t* CG = (const bf16_t*)(p.ws + WS_CG); bf16_t* MIX = (bf16_t*)(p.ws + WS_MIX);
    const int g = tid & 127, sub = tid >> 7;
    const f32x4 w0 = *(const f32x4*)(p.conv_w + 4 * g), w1 = *(const f32x4*)(p.conv_w + 512 + 4 * g), w2 = *(const f32x4*)(p.conv_w + 1024 + 4 * g), cb = *(const f32x4*)(p.conv_b + 4 * g);
#define LO16(u) __builtin_bit_cast(float, (u) << 16)
#define HI16(u) __builtin_bit_cast(float, (u) & 0xffff0000u)
    for (int chunk = blockIdx.x; chunk < MLAT / 32; chunk += G) {
        const int tok0 = chunk * 32 + sub * 8, t0 = tok0 & (SEQ - 1);
        const bf16_t* src = CG + (size_t)tok0 * 1024 + g * 8;
        u32x4 cur[8]; u32x2 pv = {0u, 0u}, nv = {0u, 0u};
#pragma unroll
        for (int k = 0; k < 8; ++k) cur[k] = *(const u32x4*)(src + (size_t)k * 1024);
        if (t0 > 0) pv = *(const u32x2*)(src - 1024);
        if (t0 + 8 < SEQ) nv = *(const u32x2*)(src + 8 * 1024);
        f32x4 cprev = {LO16(pv.x), HI16(pv.x), LO16(pv.y), HI16(pv.y)};
        f32x4 cc = {LO16(cur[0].x), HI16(cur[0].x), LO16(cur[0].y), HI16(cur[0].y)};
#pragma unroll
        for (int k = 0; k < 8; ++k) {
            const u32x2 nx = (k < 7) ? (u32x2){cur[k < 7 ? k + 1 : 7].x, cur[k < 7 ? k + 1 : 7].y} : nv;
            const f32x4 cn = {LO16(nx.x), HI16(nx.x), LO16(nx.y), HI16(nx.y)};
            const f32x4 gz = {LO16(cur[k].z), HI16(cur[k].z), LO16(cur[k].w), HI16(cur[k].w)};
            const f32x4 y = gz * (cb + w0 * cprev + w1 * cc + w2 * cn);
            u32x2 w; w.x = cvtpk(y[0], y[1]); w.y = cvtpk(y[2], y[3]);
            *(u32x2*)(MIX + (size_t)(tok0 + k) * DM + 512 + 4 * g) = w;
            cprev = cc; cc = cn;
        }
    }
#undef LO16
#undef HI16
}

#define XB_TMO      128
#define XB_XCNT(j)  (256  + 64 * (j))
#define XB_XSUB(j)  (1280 + 64 * (j))
#define XB_XGEN(j)  (2304 + 64 * (j))
#define XB_TOP      3328
#define XB_TOPGEN   3392
#define XCD_BAR_WORDS 3456
#define XB_SPIN_CAP (1u << 18)
__device__ __forceinline__ unsigned xb_ld(unsigned* p)              { return __hip_atomic_load(p, __ATOMIC_RELAXED, __HIP_MEMORY_SCOPE_AGENT); }
__device__ __forceinline__ unsigned xb_add(unsigned* p, unsigned v) { return __hip_atomic_fetch_add(p, v, __ATOMIC_RELAXED, __HIP_MEMORY_SCOPE_AGENT); }
__device__ __forceinline__ unsigned xb_xcc_id() { return (unsigned)__builtin_amdgcn_s_getreg((3 << 11) | 20) & 0xFu; }
#define XB_SPIN(cond, bar) do { unsigned _sp = 0; while (cond) { __builtin_amdgcn_s_sleep(1); \
    if ((++_sp & 255u) == 0u) { if (xb_ld(&(bar)[XB_TMO])) break; if (_sp > XB_SPIN_CAP) { atomicAdd(&(bar)[XB_TMO], 1u); break; } } } } while (0)
struct XcdBarrier { unsigned* bar; unsigned x; volatile LAS unsigned* st; };
__device__ __forceinline__ XcdBarrier xcd_barrier_post(unsigned* bar, volatile LAS unsigned* st) {
    XcdBarrier b; b.bar = bar; b.x = xb_xcc_id(); b.st = st;
    if (threadIdx.x == 0) (void)xb_add(&bar[XB_XCNT(b.x)], 1u);
    return b;
}
__device__ __forceinline__ void xcd_barrier_complete(unsigned* bar, unsigned x, unsigned& nloc, unsigned& nx) {
    const unsigned G = gridDim.x * gridDim.y * gridDim.z;
    unsigned sum, cnt, mine, sp = 0u;
    for (;;) {
        sum = 0u; cnt = 0u; mine = 0u;
#pragma unroll
        for (unsigned j = 0; j < 16; ++j) { const unsigned c = xb_ld(&bar[XB_XCNT(j)]); sum += c; cnt += (c > 0u) ? 1u : 0u; mine = (j == x) ? c : mine; }
        if (sum == G) break;
        __builtin_amdgcn_s_sleep(1);
        if ((++sp & 255u) == 0u) { if (xb_ld(&bar[XB_TMO])) break; if (sp > XB_SPIN_CAP) { atomicAdd(&bar[XB_TMO], 1u); break; } }
    }
    nloc = mine > 0u ? mine : 1u; nx = cnt > 0u ? cnt : 1u;
}
__device__ __forceinline__ void xcd_barrier(const XcdBarrier& b) {
    asm volatile("s_waitcnt vmcnt(0)" ::: "memory");
    __syncthreads();
    if (threadIdx.x == 0) {
        unsigned* bar = b.bar;
        __builtin_amdgcn_s_waitcnt(0);
        unsigned nloc = b.st[0], nx = b.st[1];
        if (nloc == 0u) { xcd_barrier_complete(bar, b.x, nloc, nx); b.st[0] = nloc; b.st[1] = nx; }
        const unsigned old = xb_add(&bar[XB_XSUB(b.x)], 1u);
        const unsigned gen = old / nloc;
        if (old + 1u == (gen + 1u) * nloc) {
            __builtin_amdgcn_fence(__ATOMIC_RELEASE, "agent");
            asm volatile("s_waitcnt vmcnt(0)" ::: "memory");
            const unsigned og = xb_add(&bar[XB_TOP], 1u);
            const unsigned tg = og / nx;
            if (og + 1u == (tg + 1u) * nx) xb_add(&bar[XB_TOPGEN], 1u);
            else XB_SPIN(xb_ld(&bar[XB_TOPGEN]) == tg, bar);
            __builtin_amdgcn_fence(__ATOMIC_ACQUIRE, "agent");
            xb_add(&bar[XB_XGEN(b.x)], 1u);
            asm volatile("s_waitcnt vmcnt(0)" ::: "memory");
        } else {
            XB_SPIN(xb_ld(&bar[XB_XGEN(b.x)]) == gen, bar);
            __builtin_amdgcn_fence(__ATOMIC_ACQUIRE, "agent");
            asm volatile("s_waitcnt vmcnt(0)" ::: "memory");
        }
    }
    __syncthreads();
}

__global__ void __launch_bounds__(NTHREADS, 2) fwd_megakernel(Params p) {
    extern __shared__ __attribute__((aligned(16))) unsigned char lds_raw[];
    LAS unsigned char* lds = (LAS unsigned char*)lds_raw;
    cg::grid_group grid = cg::this_grid();
    if (threadIdx.x < 16) ((LAS unsigned*)(lds + LDS_MISC))[threadIdx.x] = 0u;
    __syncthreads();
    XcdBarrier xbar = xcd_barrier_post((unsigned*)(p.ws + WS_BAR), (volatile LAS unsigned*)(lds + LDS_MISC));
    if (p.ph_lo < 0) grid.sync();
#define GSYNC() xcd_barrier(xbar)
    const int lo = p.ph_lo, hi = p.ph_hi;
    const int x = blockIdx.x & 7, lb = blockIdx.x >> 3, nb = gridDim.x >> 3;
    EpiCtx E;
    E.QP = (bf16_t*)(p.ws + WS_QP); E.QR = (bf16_t*)(p.ws + WS_QR); E.KR = (bf16_t*)(p.ws + WS_KR); E.KC = (bf16_t*)(p.ws + WS_KC);
    E.VT = (bf16_t*)(p.ws + WS_VT); E.ZA = (bf16_t*)(p.ws + WS_ZA); E.CG = (bf16_t*)(p.ws + WS_CG);
    E.gq = p.q_norm_g; E.gk = p.k_norm_g; E.rope = (const float*)(p.ws + WS_ROPE);
    E.x = p.x; E.gate = (const float*)(p.ws + WS_GATE); E.out = p.out;
#define IN(k) (lo <= (k) && (k) < hi)
#define SEAM(k) do { if (IN(k) && IN((k) + 1)) GSYNC(); } while (0)
#define REP(k, ...) do { if (IN(k)) { __VA_ARGS__; if (PROBE_REP == (k)) { GSYNC(); __VA_ARGS__; } } } while (0)
    REP(0, phase0(p, lds));
    SEAM(0);
    REP(1, phase1(p, lds));
    SEAM(1);
    REP(2, { SchedP2 S{x, lb, nb, (const char*)(p.ws + WS_XN), (const char*)(p.ws + WS_WT)}; gemm_phase<2>(lds, S, E); });
    SEAM(2);
    REP(3, phase3(p, lds));
    if (IN(3)) { phase3_conv(p); if (PROBE_REP == 31) { GSYNC(); phase3_conv(p); } }
    SEAM(3);
    REP(4, { SchedP4 S{x, lb, nb, (const char*)(p.ws + WS_MIX), (const char*)(p.ws + WS_WO)}; gemm_phase<4>(lds, S, E); });
#undef REP
    if (PROBE_REP == 99) { GSYNC(); GSYNC(); GSYNC(); GSYNC(); }
#undef IN
#undef SEAM
}

extern "C" void kernel_launch(void* const* d_in, const int* in_sizes, int n_in, void* d_out, int out_size, void* d_ws, size_t ws_size, hipStream_t stream) {
    static int grid = 0;
    if (grid == 0) {
        int dev = 0, cus = 0, per_cu = 0;
        hipGetDevice(&dev);
        hipDeviceGetAttribute(&cus, hipDeviceAttributeMultiprocessorCount, dev);
        if (hipFuncSetAttribute((const void*)fwd_megakernel, hipFuncAttributeMaxDynamicSharedMemorySize, LDS_BYTES) != hipSuccess) { fprintf(stderr, "hipFuncSetAttribute failed\n"); grid = -1; return; }
        hipOccupancyMaxActiveBlocksPerMultiprocessor(&per_cu, (const void*)fwd_megakernel, NTHREADS, LDS_BYTES);
        if (per_cu < 1) { fprintf(stderr, "occupancy query says %d blocks per CU\n", per_cu); grid = -1; return; }
        grid = cus;
        grid -= grid % 8;
        if (n_in != 14 || ws_size < WS_END || grid < 8) { fprintf(stderr, "unexpected problem geometry\n"); grid = -1; return; }
    }
    if (grid < 0) return;
    Params p{};
    p.x = (const float*)d_in[0]; p.c = (const float*)d_in[1]; p.ctx = (const float*)d_in[2]; p.c_ctx = (const float*)d_in[3];
    p.w_ada = (const float*)d_in[4]; p.b_ada = (const float*)d_in[5]; p.norm_g = (const float*)d_in[6]; p.w_in = (const float*)d_in[7];
    p.q_norm_g = (const float*)d_in[8]; p.k_norm_g = (const float*)d_in[9]; p.rpb = (const float*)d_in[10]; p.conv_w = (const float*)d_in[11];
    p.conv_b = (const float*)d_in[12]; p.w_out = (const float*)d_in[13];
    p.out = (float*)d_out; p.ws = (unsigned char*)d_ws;
    if (hipMemsetAsync((char*)d_ws + WS_BAR, 0, BAR_BYTES, stream) != hipSuccess) { fprintf(stderr, "memset of barrier words failed\n"); return; }
#if N_LAUNCH_MODE == 1
    p.ph_lo = 0; p.ph_hi = 5;
    void* args[] = {&p};
    hipError_t e = hipLaunchCooperativeKernel((const void*)fwd_megakernel, dim3(grid), dim3(NTHREADS), args, LDS_BYTES, stream);
    if (e != hipSuccess) fprintf(stderr, "cooperative launch failed: %s (grid %d)\n", hipGetErrorString(e), grid);
#else
    for (int ph = 0; ph < 5; ++ph) {
        p.ph_lo = ph; p.ph_hi = ph + 1;
        hipLaunchKernelGGL(fwd_megakernel, dim3(grid), dim3(NTHREADS), LDS_BYTES, stream, p);
    }
#endif
}
```

```cpp
#include <hip/hip_runtime.h>
#include <hip/hip_cooperative_groups.h>
#include <cstdio>
#include <cstdint>
namespace cg = cooperative_groups;

#ifndef N_LAUNCH_MODE
#define N_LAUNCH_MODE 1
#endif

#ifndef PROBE_REP
#define PROBE_REP -1
#endif

#define LAS __attribute__((address_space(3)))
typedef unsigned short bf16_t;
typedef short bf16x8 __attribute__((ext_vector_type(8)));
typedef float f32x4 __attribute__((ext_vector_type(4)));
typedef float f32x2 __attribute__((ext_vector_type(2)));
typedef unsigned u32x4 __attribute__((ext_vector_type(4)));
typedef unsigned u32x2 __attribute__((ext_vector_type(2)));
typedef __bf16 bf16x2_t __attribute__((ext_vector_type(2)));

constexpr int NBATCH = 8, SEQ = 2048, DM = 1024, CTXL = 256, NH = 8, HD = 64;
constexpr int MLAT = NBATCH * SEQ, MCTX = NBATCH * CTXL, MTOT = MLAT + MCTX;
constexpr int DIN = 4096, NADA = 3072;
constexpr float RMS_EPS = 1e-6f;
constexpr float LOG2E = 1.4426950408889634f;

constexpr size_t MiB = 1u << 20;
constexpr size_t WS_WT = 0;
constexpr size_t WS_WO = 8 * MiB;
constexpr size_t WS_ADAP = 196 * MiB;
constexpr size_t WS_GATE = 11 * MiB;
constexpr size_t WS_ROPE = 11 * MiB + 65536;
constexpr size_t WS_BND = 11 * MiB + 131072;
constexpr size_t WS_BAR = 11 * MiB + 262144;
constexpr size_t BAR_BYTES = 16384;
constexpr int LDS_MISC = 147456 - 64;
constexpr size_t WS_XN = 12 * MiB;
constexpr size_t WS_QP = 48 * MiB;
constexpr size_t WS_QR = 64 * MiB;
constexpr size_t WS_KR = 80 * MiB;
constexpr size_t WS_KC = 96 * MiB;
constexpr size_t WS_VT = 98 * MiB;
constexpr size_t WS_ZA = 116 * MiB;
constexpr size_t WS_CG = 132 * MiB;
constexpr size_t WS_MIX = 164 * MiB;
constexpr size_t WS_END = 198 * MiB;

constexpr int LDS_BYTES = 147456;
constexpr int NTHREADS = 512;

struct Params {
    const float *x, *c, *ctx, *c_ctx, *w_ada, *b_ada, *norm_g, *w_in, *q_norm_g, *k_norm_g, *rpb, *conv_w, *conv_b, *w_out;
    float* out; unsigned char* ws; int ph_lo, ph_hi;
};

__device__ __forceinline__ unsigned cvtpk(float lo, float hi) { f32x2 v = {lo, hi}; bf16x2_t b = __builtin_convertvector(v, bf16x2_t); return __builtin_bit_cast(unsigned, b); }
__device__ __forceinline__ float bf2f(unsigned short h) { return __builtin_bit_cast(float, (unsigned)h << 16); }
__device__ __forceinline__ float silu_f(float v) { return v * __builtin_amdgcn_rcpf(1.0f + __builtin_amdgcn_exp2f(-v * LOG2E)); }
__device__ __forceinline__ float wave_sum(float v) {
#pragma unroll
    for (int o = 1; o < 64; o <<= 1) v += __shfl_xor(v, o);
    return v;
}

constexpr int BM = 256, BK = 64, HALF = 128, HTB = HALF * BK * 2, KDIM = 1024;
constexpr size_t TSTEP = (size_t)BM * KDIM * 2;
__device__ __forceinline__ int lds_byte(int r, int c) { const int st = (r >> 4) * 2 + (c >> 5), rr = r & 15, cc = c & 31, ob = rr * 64 + cc * 2; return st * 1024 + (ob ^ (((ob >> 9) & 1) << 5)); }
__device__ __forceinline__ void stage_rc(int b, int& R, int& C) { const int st = b / 1024, sb = b % 1024, swz = sb ^ (((sb >> 9) & 1) << 5); R = (st >> 1) * 16 + swz / 64; C = (st & 1) * 32 + (swz % 64) / 2; }
__device__ __forceinline__ int perm32(int rho) { const int n = rho >> 4, i = rho & 15; return 8 * (i >> 2) + 4 * n + (i & 3); }

struct Unit { const char* a; const char* b; int kind, pm, pn; };

struct EpiCtx {
    bf16_t *QP, *QR, *KR, *KC, *VT, *ZA, *CG;
    const float *gq, *gk, *rope;
    const float *x, *gate; float* out;
};

template <int PH>
__device__ __forceinline__ void epilogue(const f32x4 (&acc)[2][2][4][2], const Unit& u, int wr, int wc, int fr, int fq, const EpiCtx& E) {
    if constexpr (PH == 4) {
        const int b = (u.pm * BM) >> 11;
        const int c0 = u.pn * BM + wc * 32 + fq * 8;
        f32x4 gv[2][2];
#pragma unroll
        for (int bj = 0; bj < 2; ++bj)
#pragma unroll
            for (int n = 0; n < 2; ++n) gv[bj][n] = *(const f32x4*)(E.gate + b * DM + c0 + bj * HALF + 4 * n);
        const float* __restrict__ xp = E.x; float* __restrict__ op = E.out;
#pragma unroll
        for (int ai = 0; ai < 2; ++ai)
#pragma unroll
            for (int mp = 0; mp < 2; ++mp) {
                f32x4 xv[2][2][2];
#pragma unroll
                for (int mm = 0; mm < 2; ++mm) {
                    const size_t off = (size_t)(u.pm * BM + ai * HALF + wr * 64 + (2 * mp + mm) * 16 + fr) * DM + c0;
#pragma unroll
                    for (int bj = 0; bj < 2; ++bj)
#pragma unroll
                        for (int n = 0; n < 2; ++n) xv[mm][bj][n] = __builtin_nontemporal_load((const f32x4*)(xp + off + bj * HALF + 4 * n));
                }
#pragma unroll
                for (int mm = 0; mm < 2; ++mm) {
                    const size_t off = (size_t)(u.pm * BM + ai * HALF + wr * 64 + (2 * mp + mm) * 16 + fr) * DM + c0;
#pragma unroll
                    for (int bj = 0; bj < 2; ++bj)
#pragma unroll
                        for (int n = 0; n < 2; ++n) __builtin_nontemporal_store(xv[mm][bj][n] + gv[bj][n] * acc[ai][bj][2 * mp + mm][n], (f32x4*)(op + off + bj * HALF + 4 * n));
                }
            }
    } else {
        const int kind = u.kind;
        if (kind == 0 || kind == 1 || kind == 5) {
            const bool isq = (kind == 0);
            const float* g = isq ? E.gq : E.gk;
            const float qs = isq ? 0.125f * LOG2E : 1.0f;
            const int head = 4 * (u.pn & 1) + wc;
            f32x4 gv[2][2];
#pragma unroll
            for (int bj = 0; bj < 2; ++bj)
#pragma unroll
                for (int n = 0; n < 2; ++n) gv[bj][n] = *(const f32x4*)(g + 32 * bj + 16 * n + 4 * fq);
#pragma unroll
            for (int ai = 0; ai < 2; ++ai)
#pragma unroll
                for (int m = 0; m < 4; ++m) {
                    const int r = u.pm * BM + ai * HALF + wr * 64 + m * 16 + fr;
                    f32x4 v[2][2]; float ss = 0.f;
#pragma unroll
                    for (int bj = 0; bj < 2; ++bj)
#pragma unroll
                        for (int n = 0; n < 2; ++n) { v[bj][n] = acc[ai][bj][m][n]; const f32x4 t = v[bj][n] * v[bj][n]; ss += (t[0] + t[1]) + (t[2] + t[3]); }
                    ss += __shfl_xor(ss, 16); ss += __shfl_xor(ss, 32);
                    const float rinv = __builtin_amdgcn_rsqf(ss * (1.0f / 64.0f) + RMS_EPS) * qs;
#pragma unroll
                    for (int bj = 0; bj < 2; ++bj)
#pragma unroll
                        for (int n = 0; n < 2; ++n) v[bj][n] = v[bj][n] * rinv * gv[bj][n];
                    if (kind == 5) {
                        const int rc = r - MLAT, b = rc >> 8, l = rc & 255;
                        bf16_t* dst = E.KC + ((size_t)((b * NH + head) * CTXL + l)) * HD + fq * 16;
#pragma unroll
                        for (int bj = 0; bj < 2; ++bj) { u32x4 w; w.x = cvtpk(v[bj][0][0], v[bj][0][1]); w.y = cvtpk(v[bj][0][2], v[bj][0][3]); w.z = cvtpk(v[bj][1][0], v[bj][1][1]); w.w = cvtpk(v[bj][1][2], v[bj][1][3]); *(u32x4*)(dst + bj * 8) = w; }
                    } else {
                        const int b = r >> 11, t = r & 2047, grow = t >> 6, gcol = t & 63;
                        const size_t rowoff = ((size_t)((b * NH + head) * SEQ + t)) * HD + fq * 16;
                        if (isq) {
                            bf16_t* dst = E.QP + rowoff;
#pragma unroll
                            for (int bj = 0; bj < 2; ++bj) { u32x4 w; w.x = cvtpk(v[bj][0][0], v[bj][0][1]); w.y = cvtpk(v[bj][0][2], v[bj][0][3]); w.z = cvtpk(v[bj][1][0], v[bj][1][1]); w.w = cvtpk(v[bj][1][2], v[bj][1][3]); *(u32x4*)(dst + bj * 8) = w; }
                        }
                        bf16_t* dst = (isq ? E.QR : E.KR) + rowoff;
#pragma unroll
                        for (int bj = 0; bj < 2; ++bj) {
                            const int pos = bj ? gcol : grow;
                            const f32x4 cs = *(const f32x4*)(E.rope + pos * 16 + 4 * fq), sn = *(const f32x4*)(E.rope + 1024 + pos * 16 + 4 * fq);
                            const f32x4 o0 = v[bj][0] * cs - v[bj][1] * sn, o1 = v[bj][1] * cs + v[bj][0] * sn;
                            u32x4 w; w.x = cvtpk(o0[0], o0[1]); w.y = cvtpk(o0[2], o0[3]); w.z = cvtpk(o1[0], o1[1]); w.w = cvtpk(o1[2], o1[3]);
                            *(u32x4*)(dst + bj * 8) = w;
                        }
                    }
                }
        } else if (kind == 2) {
            const int c0 = (u.pn - 6) * BM + wc * 32 + fq * 8;
#pragma unroll
            for (int ai = 0; ai < 2; ++ai)
#pragma unroll
                for (int m = 0; m < 4; ++m) {
                    bf16_t* dst = E.ZA + (size_t)(u.pm * BM + ai * HALF + wr * 64 + m * 16 + fr) * 512 + c0;
#pragma unroll
                    for (int bj = 0; bj < 2; ++bj) {
                        const f32x4 a0 = acc[ai][bj][m][0], a1 = acc[ai][bj][m][1];
                        u32x4 w; w.x = cvtpk(silu_f(a0[0]), silu_f(a0[1])); w.y = cvtpk(silu_f(a0[2]), silu_f(a0[3])); w.z = cvtpk(silu_f(a1[0]), silu_f(a1[1])); w.w = cvtpk(silu_f(a1[2]), silu_f(a1[3]));
                        *(u32x4*)(dst + bj * HALF) = w;
                    }
                }
        } else if (kind == 3) {
            const int ch0 = (u.pn - 8) * 64 + wc * 16 + fq * 4;
#pragma unroll
            for (int ai = 0; ai < 2; ++ai)
#pragma unroll
                for (int m = 0; m < 4; ++m) {
                    const f32x4 uu = acc[ai][0][m][0], bg = acc[ai][0][m][1], cgv = acc[ai][1][m][0], zc = acc[ai][1][m][1];
                    const f32x4 cu = cgv * uu;
                    f32x4 gz;
#pragma unroll
                    for (int j = 0; j < 4; ++j) gz[j] = bg[j] * silu_f(zc[j]);
                    u32x4 w; w.x = cvtpk(cu[0], cu[1]); w.y = cvtpk(cu[2], cu[3]); w.z = cvtpk(gz[0], gz[1]); w.w = cvtpk(gz[2], gz[3]);
                    *(u32x4*)(E.CG + (size_t)(u.pm * BM + ai * HALF + wr * 64 + m * 16 + fr) * 1024 + ch0 * 2) = w;
                }
        } else {
            const int c0 = u.pn * BM + wc * 32 + fq * 8;
#pragma unroll
            for (int ai = 0; ai < 2; ++ai)
#pragma unroll
                for (int m = 0; m < 4; ++m) {
                    bf16_t* dst = E.VT + (size_t)(u.pm * BM + ai * HALF + wr * 64 + m * 16 + fr) * MTOT + c0;
#pragma unroll
                    for (int bj = 0; bj < 2; ++bj) {
                        const f32x4 a0 = acc[ai][bj][m][0], a1 = acc[ai][bj][m][1];
                        u32x4 w; w.x = cvtpk(a0[0], a0[1]); w.y = cvtpk(a0[2], a0[3]); w.z = cvtpk(a1[0], a1[1]); w.w = cvtpk(a1[2], a1[3]);
                        *(u32x4*)(dst + bj * HALF) = w;
                    }
                }
        }
    }
}

struct SchedP2 {
    int x, lb, nb; const char* XN; const char* WT;
    __device__ __forceinline__ bool next(int i, Unit& u) const {
        const int uu = lb + i * nb; if (uu >= 132) return false;
        if (uu < 112) {
            const int pi = uu >> 3, pm = 8 * x + (uu & 7), pn = pi < 4 ? pi : pi + 2;
            u.kind = pn < 2 ? 0 : (pn < 4 ? 1 : (pn < 8 ? 2 : 3)); u.pm = pm; u.pn = pn; u.a = XN + (size_t)pm * TSTEP; u.b = WT + (size_t)pn * TSTEP;
        } else if (uu < 130) {
            const int v = uu - 112, pnp = 9 * x + v % 9, pmp = v / 9;
            u.kind = 4; u.pm = pmp; u.pn = pnp; u.a = WT + (size_t)(4 + pmp) * TSTEP; u.b = XN + (size_t)pnp * TSTEP;
        } else {
            u.kind = 5; u.pm = 64 + x; u.pn = 2 + (uu - 130); u.a = XN + (size_t)u.pm * TSTEP; u.b = WT + (size_t)u.pn * TSTEP;
        }
        return true;
    }
};
struct SchedP4 {
    int x, lb, nb; const char* MIX; const char* WO;
    __device__ __forceinline__ bool next(int i, Unit& u) const {
        const int uu = lb + i * nb; if (uu >= 32) return false;
        u.kind = 6; u.pm = 8 * x + (uu & 7); u.pn = uu >> 3; u.a = MIX + (size_t)u.pm * TSTEP; u.b = WO + (size_t)u.pn * TSTEP; return true;
    }
};

template <int PH, class Sched>
__device__ __forceinline__ void gemm_phase(LAS unsigned char* lds, const Sched& S, const EpiCtx& E) {
    const int tid = threadIdx.x, wid = __builtin_amdgcn_readfirstlane(tid >> 6), lane = tid & 63, wr = wid >> 2, wc = wid & 3, fr = lane & 15, fq = lane >> 4;
    constexpr int K = KDIM, nt = K / BK;
    unsigned voffA[2], voffB[2];
#pragma unroll
    for (int i = 0; i < 2; ++i) { int R, C; stage_rc(tid * 16 + i * 8192, R, C); const int Rb = (R & ~31) + perm32(R & 31);
        voffA[i] = (unsigned)(R * K + C) * 2u; voffB[i] = (unsigned)(Rb * K + C) * 2u; }
    const size_t kstep = (size_t)(BK * 2);
    const size_t hstep = (size_t)HALF * K * 2;
    const unsigned ldsw = (unsigned)wid * 1024u;
    const int aoff = lds_byte(wr * 64 + fr, fq * 8), boff = lds_byte(wc * 32 + fr, fq * 8);
#define PG8_SA(b, h) (((b) * 2 + (h)) * HTB)
#define PG8_SB(b, h) ((4 + (b) * 2 + (h)) * HTB)
#define PG8_STAGE(bufoff, gbase, voff) do { _Pragma("unroll") for (int _i = 0; _i < 2; ++_i) \
        __builtin_amdgcn_global_load_lds((const unsigned*)((const char*)(gbase) + (voff)[_i]), (LAS unsigned*)(lds + (bufoff) + ldsw + _i * 8192), 16, 0, 0); } while (0)
#define PG8_LDA(dst, b, h) do { _Pragma("unroll") for (int m = 0; m < 4; ++m) _Pragma("unroll") for (int k = 0; k < 2; ++k) dst[m][k] = *(const LAS bf16x8*)(lds + PG8_SA(b, h) + aoff + m * 2048 + k * 1024); } while (0)
#define PG8_LDB(dst, b, h) do { _Pragma("unroll") for (int n = 0; n < 2; ++n) _Pragma("unroll") for (int k = 0; k < 2; ++k) dst[n][k] = *(const LAS bf16x8*)(lds + PG8_SB(b, h) + boff + n * 2048 + k * 1024); } while (0)
#define PG8_MMA(ai, bj, At, Bt) do { __builtin_amdgcn_s_setprio(1); _Pragma("unroll") for (int m = 0; m < 4; ++m) _Pragma("unroll") for (int n = 0; n < 2; ++n) _Pragma("unroll") for (int k = 0; k < 2; ++k) \
        acc[ai][bj][m][n] = __builtin_amdgcn_mfma_f32_16x16x32_bf16(Bt[n][k], At[m][k], acc[ai][bj][m][n], 0, 0, 0); __builtin_amdgcn_s_setprio(0); } while (0)
#define PG8_WAIT_V(n) asm volatile("s_waitcnt vmcnt(" #n ")" ::: "memory")
#define PG8_WAIT_L(n) asm volatile("s_waitcnt lgkmcnt(" #n ")" ::: "memory")
#define PG8_BAR __builtin_amdgcn_s_barrier()
#define PG8_SCHED __builtin_amdgcn_sched_barrier(0)
    Unit cur, nxt; int ui = 0;
    if (!S.next(0, cur)) return;
    f32x4 acc[2][2][4][2];
#pragma unroll
    for (int a = 0; a < 2; ++a)
#pragma unroll
        for (int b = 0; b < 2; ++b)
#pragma unroll
            for (int m = 0; m < 4; ++m)
#pragma unroll
                for (int n = 0; n < 2; ++n) acc[a][b][m][n] = (f32x4){0.f, 0.f, 0.f, 0.f};
    bf16x8 At[4][2], B0[2][2], B1[2][2];
    const char* cA = cur.a; const char* cB = cur.b;
    PG8_STAGE(PG8_SB(0, 0), cB, voffB); PG8_STAGE(PG8_SB(0, 1), cB + hstep, voffB); PG8_STAGE(PG8_SA(0, 0), cA, voffA); PG8_STAGE(PG8_SA(0, 1), cA + hstep, voffA);
    if (wr == 1) PG8_BAR;
    PG8_WAIT_V(2); PG8_BAR;
    PG8_STAGE(PG8_SB(1, 0), cB + kstep, voffB); PG8_STAGE(PG8_SA(1, 0), cA + kstep, voffA); PG8_STAGE(PG8_SB(1, 1), cB + hstep + kstep, voffB);
    PG8_WAIT_V(6); PG8_BAR;
    for (;;) {
        const bool has_next = S.next(ui + 1, nxt);
        const char* nA = has_next ? nxt.a : cA; const char* nB = has_next ? nxt.b : cB;
        for (int t = 0; t < nt; t += 2) {
            const bool last = (t == nt - 2);
            const char* a1 = cA + (size_t)(t + 1) * kstep;
            const char* a2 = last ? nA : cA + (size_t)(t + 2) * kstep; const char* b2 = last ? nB : cB + (size_t)(t + 2) * kstep;
            const char* a3 = a2 + kstep; const char* b3 = b2 + kstep;
            PG8_LDB(B0, 0, 0); PG8_LDB(B1, 0, 1); PG8_SCHED; PG8_LDA(At, 0, 0); PG8_STAGE(PG8_SA(1, 1), a1 + hstep, voffA);
            PG8_WAIT_V(8); PG8_WAIT_L(0); PG8_BAR; PG8_MMA(0, 0, At, B0); PG8_MMA(0, 1, At, B1); PG8_BAR; PG8_SCHED;
            PG8_LDA(At, 0, 1); PG8_STAGE(PG8_SB(0, 0), b2, voffB); PG8_STAGE(PG8_SB(0, 1), b2 + hstep, voffB); PG8_STAGE(PG8_SA(0, 0), a2, voffA);
            PG8_WAIT_V(8); PG8_WAIT_L(0); PG8_BAR; PG8_MMA(1, 0, At, B0); PG8_MMA(1, 1, At, B1); PG8_BAR; PG8_SCHED;
            PG8_LDB(B0, 1, 0); PG8_LDB(B1, 1, 1); PG8_SCHED; PG8_LDA(At, 1, 0); PG8_STAGE(PG8_SA(0, 1), a2 + hstep, voffA);
            PG8_WAIT_V(8); PG8_WAIT_L(0); PG8_BAR; PG8_MMA(0, 0, At, B0); PG8_MMA(0, 1, At, B1); PG8_BAR; PG8_SCHED;
            PG8_LDA(At, 1, 1); PG8_STAGE(PG8_SB(1, 0), b3, voffB); PG8_STAGE(PG8_SB(1, 1), b3 + hstep, voffB); PG8_STAGE(PG8_SA(1, 0), a3, voffA);
            PG8_WAIT_V(8); PG8_WAIT_L(0); PG8_BAR; PG8_MMA(1, 0, At, B0); PG8_MMA(1, 1, At, B1); PG8_BAR; PG8_SCHED;
        }
        if (wr == 0) PG8_BAR;
        epilogue<PH>(acc, cur, wr, wc, fr, fq, E);
        if (!has_next) break;
#pragma unroll
        for (int a = 0; a < 2; ++a)
#pragma unroll
            for (int b = 0; b < 2; ++b)
#pragma unroll
                for (int m = 0; m < 4; ++m)
#pragma unroll
                    for (int n = 0; n < 2; ++n) acc[a][b][m][n] = (f32x4){0.f, 0.f, 0.f, 0.f};
        cur = nxt; cA = nA; cB = nB; ++ui;
        if (wr == 1) PG8_BAR;
    }
    PG8_WAIT_V(0);
    PG8_BAR;
#undef PG8_SA
#undef PG8_SB
#undef PG8_STAGE
#undef PG8_LDA
#undef PG8_LDB
#undef PG8_MMA
#undef PG8_WAIT_V
#undef PG8_WAIT_L
#undef PG8_BAR
#undef PG8_SCHED
}

__device__ __forceinline__ int wt_dst_row(int c) {
    if (c < 1024) {
        const int base = c & ~511, local = c & 511, head = local >> 6, d = local & 63;
        const int pnl = head >> 2, wc = head & 3, bj = d >> 5, n = (d >> 4) & 1, f = d & 15, fq = f >> 2, j = f & 3;
        return base + pnl * 256 + 128 * bj + 32 * wc + 8 * fq + 4 * n + j;
    } else if (c < 2048) {
        return c;
    } else {
        const int type = (c - 2048) >> 9, ch = (c - 2048) & 511, ct = ch >> 6, chl = ch & 63;
        const int wc = chl >> 4, fq = (chl >> 2) & 3, j = chl & 3, bj = type >> 1, n = type & 1;
        return 2048 + ct * 256 + 128 * bj + 32 * wc + 8 * fq + 4 * n + j;
    }
}
template <bool PERMUTE>
__device__ __forceinline__ void p0_transpose_item(const float* W, int N, bf16_t* WT, LAS float* scr, int item, int lane) {
    const int nblk = N / 32, kb = item / nblk, nb = item % nblk, k0 = 64 * kb, n0 = 32 * nb;
    const int loff = (lane >> 5) * N + (lane & 31);
#pragma unroll
    for (int hh = 0; hh < 2; ++hh) {
        float tv[16];
#pragma unroll
        for (int i = 0; i < 16; ++i) { const float* wu = W + (size_t)(k0 + 2 * (16 * hh + i)) * N + n0; tv[i] = wu[loff]; }
#pragma unroll
        for (int i = 0; i < 16; ++i) scr[(2 * (16 * hh + i) + (lane >> 5)) * 33 + (lane & 31)] = tv[i];
    }
    asm volatile("s_waitcnt lgkmcnt(0)" ::: "memory");
    const int c = lane & 7;
#pragma unroll
    for (int j = 0; j < 4; ++j) { const int n = (lane >> 3) + 8 * j; const LAS float* s = scr + (8 * c) * 33 + n;
        u32x4 o; o.x = cvtpk(s[0 * 33], s[1 * 33]); o.y = cvtpk(s[2 * 33], s[3 * 33]); o.z = cvtpk(s[4 * 33], s[5 * 33]); o.w = cvtpk(s[6 * 33], s[7 * 33]);
        const int drow = PERMUTE ? wt_dst_row(n0 + n) : (n0 + n);
        *(u32x4*)(WT + (size_t)drow * KDIM + k0 + 8 * c) = o; }
    asm volatile("s_waitcnt lgkmcnt(0)" ::: "memory");
}

__device__ __forceinline__ void phase0(const Params& p, LAS unsigned char* lds) {
    const int tid = threadIdx.x, lane = tid & 63, wave = __builtin_amdgcn_readfirstlane(tid >> 6);
    const int G = gridDim.x;
    LAS float* scr = (LAS float*)(lds + wave * 8704);
    bf16_t* WT = (bf16_t*)(p.ws + WS_WT); bf16_t* WO = (bf16_t*)(p.ws + WS_WO);
    float* ADAP = (float*)(p.ws + WS_ADAP);
    const int gw = wave * G + blockIdx.x, NGW = G * 8;
    constexpr int N_ADA = 1536, N_TIN = (KDIM / 64) * (DIN / 32), N_TOUT = (KDIM / 64) * (DM / 32);
    for (int it = gw; it < N_ADA + N_TIN + N_TOUT; it += NGW) {
        if (it < N_ADA) {
            const int cgp = it % 96, kc = it / 96, col = cgp * 32 + (lane & 31), kh = (lane >> 5) * 32, k0 = kc * 64;
#pragma unroll
            for (int r = 0; r < 9; ++r) { const float v = (r < 8) ? p.c[r * 1024 + k0 + lane] : p.c_ctx[k0 + lane]; scr[r * 64 + lane] = v * (1.0f / (1.0f + __expf(-v))); }
            asm volatile("s_waitcnt lgkmcnt(0)" ::: "memory");
            float a[9];
#pragma unroll
            for (int r = 0; r < 9; ++r) a[r] = 0.f;
            const float* wp = p.w_ada + (size_t)(k0 + kh) * NADA + col;
#pragma unroll 16
            for (int kk = 0; kk < 32; ++kk) {
                const float w = wp[(size_t)kk * NADA];
#pragma unroll
                for (int r = 0; r < 9; ++r) a[r] += scr[r * 64 + kh + kk] * w;
            }
#pragma unroll
            for (int r = 0; r < 9; ++r) { a[r] += __shfl_xor(a[r], 32); if (lane < 32) ADAP[(size_t)(kc * 9 + r) * NADA + col] = a[r]; }
            asm volatile("s_waitcnt lgkmcnt(0)" ::: "memory");
        } else if (it < N_ADA + N_TIN) {
            p0_transpose_item<true>(p.w_in, DIN, WT, scr, it - N_ADA, lane);
        } else {
            p0_transpose_item<false>(p.w_out, DM, WO, scr, it - N_ADA - N_TIN, lane);
        }
    }
    if (blockIdx.x == 0) {
        float* rope = (float*)(p.ws + WS_ROPE);
        if (tid < 16) {
            double inv = 1.0; for (int i = 0; i < tid; ++i) inv *= 0.5623413251903491;
            const double a = (double)(float)inv;
            double s = 0.0, c = 0.0, term = 1.0;
            for (int n = 0; n < 24; ++n) { if ((n & 1) == 0) c += ((n & 2) ? -term : term); else s += ((n & 2) ? -term : term); term *= a / (double)(n + 1); }
            double cp = 1.0, sp = 0.0;
            for (int pos = 0; pos < 64; ++pos) { rope[pos * 16 + tid] = (float)cp; rope[1024 + pos * 16 + tid] = (float)sp; const double cn = cp * c - sp * s, sn = sp * c + cp * s; cp = cn; sp = sn; }
        }
        if (wave == 1) {
            float mq = fabsf(p.q_norm_g[lane]), mk = fabsf(p.k_norm_g[lane]), mr = 0.f;
            for (int i = lane; i < NH * 15 * 31; i += 64) mr = fmaxf(mr, fabsf(p.rpb[i]));
#pragma unroll
            for (int o = 1; o < 64; o <<= 1) { mq = fmaxf(mq, __shfl_xor(mq, o)); mk = fmaxf(mk, __shfl_xor(mk, o)); mr = fmaxf(mr, __shfl_xor(mr, o)); }
            if (lane == 0) *(float*)(p.ws + WS_BND) = (8.0f * mq * mk + mr) * LOG2E;
        }
    }
}

template <int NR>
__device__ __forceinline__ void p1_rows(const float* src0, bf16_t* dst0, const LAS float* mult, const LAS float* shf, int lane) {
    f32x4 v[NR][4];
#pragma unroll
    for (int r = 0; r < NR; ++r)
#pragma unroll
        for (int j = 0; j < 4; ++j) v[r][j] = __builtin_nontemporal_load((const f32x4*)(src0 + (size_t)r * DM) + lane + 64 * j);
#pragma unroll
    for (int r = 0; r < NR; ++r) {
        float s = 0.f;
#pragma unroll
        for (int j = 0; j < 4; ++j) { const f32x4 t = v[r][j] * v[r][j]; s += (t[0] + t[1]) + (t[2] + t[3]); }
        const float rinv = __builtin_amdgcn_rsqf(wave_sum(s) * (1.0f / DM) + RMS_EPS);
        u32x2* o8 = (u32x2*)(dst0 + (size_t)r * DM) + lane;
#pragma unroll
        for (int j = 0; j < 4; ++j) {
            const f32x4 mu = *(const LAS f32x4*)(mult + 4 * lane + 256 * j), sv = *(const LAS f32x4*)(shf + 4 * lane + 256 * j);
            const f32x4 h = v[r][j] * rinv * mu + sv;
            u32x2 w; w.x = cvtpk(h[0], h[1]); w.y = cvtpk(h[2], h[3]); o8[64 * j] = w;
        }
    }
}
__device__ __forceinline__ void phase1(const Params& p, LAS unsigned char* lds) {
    const int tid = threadIdx.x, lane = tid & 63, wave = __builtin_amdgcn_readfirstlane(tid >> 6);
    LAS float* multL = (LAS float*)lds; LAS float* shfL = (LAS float*)(lds + 4096); LAS float* multC = (LAS float*)(lds + 8192); LAS float* shfC = (LAS float*)(lds + 12288);
    const float* ADAP = (const float*)(p.ws + WS_ADAP);
    bf16_t* XN = (bf16_t*)(p.ws + WS_XN); float* GATE = (float*)(p.ws + WS_GATE);
    for (int slot = blockIdx.x; slot < 256; slot += gridDim.x) {
        const int ci = slot >> 5;
        __syncthreads();
        for (int k = tid; k < 1024; k += NTHREADS) {
            float sh = p.b_ada[k], scl = p.b_ada[1024 + k], shc = sh, sclc = scl;
#pragma unroll
            for (int kc = 0; kc < 16; ++kc) {
                sh += ADAP[(size_t)(kc * 9 + ci) * NADA + k]; scl += ADAP[(size_t)(kc * 9 + ci) * NADA + 1024 + k];
                shc += ADAP[(size_t)(kc * 9 + 8) * NADA + k]; sclc += ADAP[(size_t)(kc * 9 + 8) * NADA + 1024 + k];
            }
            const float g = p.norm_g[k];
            multL[k] = g * (1.0f + scl); shfL[k] = sh; multC[k] = g * (1.0f + sclc); shfC[k] = shc;
            if ((slot & 31) == 0) {
                float gt = p.b_ada[2048 + k];
#pragma unroll
                for (int kc = 0; kc < 16; ++kc) gt += ADAP[(size_t)(kc * 9 + ci) * NADA + 2048 + k];
                GATE[ci * DM + k] = gt;
            }
        }
        __syncthreads();
        const size_t r0 = (size_t)slot * 64 + wave * 8;
        p1_rows<4>(p.x + r0 * DM, XN + r0 * DM, multL, shfL, lane);
        p1_rows<4>(p.x + (r0 + 4) * DM, XN + (r0 + 4) * DM, multL, shfL, lane);
        { const size_t rc = (size_t)slot * 8 + wave; p1_rows<1>(p.ctx + rc * DM, XN + ((size_t)MLAT + rc) * DM, multC, shfC, lane); }
    }
}

constexpr int A_CH = 13, A_NS = 6, A_D = 5, A_RING = 32768, A_SLOT = 16384;
__device__ __forceinline__ int swz_k(int key) { return ((key >> 1) & 1) * 2 + ((key >> 3) & 1) * 4; }
__device__ __forceinline__ int swz_v(int d) { return ((d >> 1) & 1) * 2 + ((d >> 2) & 1) * 4; }

__device__ __forceinline__ void glds16(const void* gsrc, unsigned lds_dst) { unsigned keep;
    asm volatile("s_mov_b32 %0, m0\n\ts_mov_b32 m0, %2\n\ts_nop 0\n\tglobal_load_lds_dwordx4 %1, off\n\ts_mov_b32 m0, %0" : "=&s"(keep) : "v"(gsrc), "s"(lds_dst) : "memory"); }

__device__ __forceinline__ void gload16_async(bf16x8& dst, const void* ptr) { asm volatile("global_load_dwordx4 %0, %1, off" : "+v"(dst) : "v"(ptr) : "memory"); }
__device__ __forceinline__ void gload8_async(u32x2& dst, const void* ptr) { asm volatile("global_load_dwordx2 %0, %1, off" : "+v"(dst) : "v"(ptr) : "memory"); }

template <bool LAT>
__device__ __forceinline__ void att_blk(const LAS unsigned char* kc, unsigned ko0, unsigned ko1, const LAS unsigned char* vc, unsigned vo,
                                        const bf16x8 q0, const bf16x8 q1, const LAS float* tb, float B2, unsigned vmask, f32x4 (&o)[4], float& lsum) {
    const bf16x8 k00 = *(const LAS bf16x8*)(kc + ko0), k01 = *(const LAS bf16x8*)(kc + ko1), k10 = *(const LAS bf16x8*)(kc + ko0 + 512), k11 = *(const LAS bf16x8*)(kc + ko1 + 512);
    bf16x8 vf[4];
#pragma unroll
    for (int db = 0; db < 4; ++db) vf[db] = *(const LAS bf16x8*)(vc + vo + db * 2048);
    const f32x4 zero4 = {0.f, 0.f, 0.f, 0.f};
    f32x4 s0 = __builtin_amdgcn_mfma_f32_16x16x32_bf16(k00, q0, zero4, 0, 0, 0); s0 = __builtin_amdgcn_mfma_f32_16x16x32_bf16(k01, q1, s0, 0, 0, 0);
    f32x4 s1 = __builtin_amdgcn_mfma_f32_16x16x32_bf16(k10, q0, zero4, 0, 0, 0); s1 = __builtin_amdgcn_mfma_f32_16x16x32_bf16(k11, q1, s1, 0, 0, 0);
    float pj[8];
#pragma unroll
    for (int j = 0; j < 8; ++j) {
        const float sv = (j < 4 ? s0[j] : s1[j - 4]);
        if (LAT) { const float e = __builtin_amdgcn_exp2f(sv + tb[j]); pj[j] = ((vmask >> j) & 1u) ? e : 0.f; }
        else pj[j] = __builtin_amdgcn_exp2f(sv - B2);
        lsum += pj[j];
    }
    u32x4 pw; pw.x = cvtpk(pj[0], pj[1]); pw.y = cvtpk(pj[2], pj[3]); pw.z = cvtpk(pj[4], pj[5]); pw.w = cvtpk(pj[6], pj[7]);
    const bf16x8 pb = __builtin_bit_cast(bf16x8, pw);
#pragma unroll
    for (int db = 0; db < 4; ++db) o[db] = __builtin_amdgcn_mfma_f32_16x16x32_bf16(vf[db], pb, o[db], 0, 0, 0);
}

__device__ __forceinline__ void phase3(const Params& p, LAS unsigned char* lds) {
    const int tid = threadIdx.x, lane = tid & 63, wave = __builtin_amdgcn_readfirstlane(tid >> 6);
    LAS float* btab = (LAS float*)lds;
    const float B2 = *(const float*)(p.ws + WS_BND);
    for (int idx = tid; idx < NH * 15 * 64; idx += NTHREADS) {
        const int c = idx & 63, hd = idx >> 6; const int dc = min(max(c - 16, 0), 30);
        btab[idx] = p.rpb[hd * 31 + dc] * LOG2E - B2;
    }
    __syncthreads();
    const int G = gridDim.x, x = blockIdx.x & 7, lb = blockIdx.x >> 3, nb = G >> 3;
    const bf16_t* QP = (const bf16_t*)(p.ws + WS_QP); const bf16_t* QR = (const bf16_t*)(p.ws + WS_QR);
    const bf16_t* KR = (const bf16_t*)(p.ws + WS_KR); const bf16_t* KC = (const bf16_t*)(p.ws + WS_KC);
    const bf16_t* VT = (const bf16_t*)(p.ws + WS_VT); const bf16_t* ZA = (const bf16_t*)(p.ws + WS_ZA);
    bf16_t* MIXo = (bf16_t*)(p.ws + WS_MIX);
    const unsigned lds0 = (unsigned)(size_t)lds;
    const int n_items = lb < 128 ? (128 - lb + nb - 1) / nb : 0;
    const int total = n_items * A_CH;
    const int ioff = wave >> 2, qc = wave & 3;
    const int q16 = lane & 15, quad = lane >> 4;
    const int qcol = qc * 16 + q16;
    const int cs = (qc == 0) ? 0 : (qc == 1) ? 8 : (qc == 2) ? 24 : 32;
    const int lo = min(max(qcol - 8, 0), 48);
    const int kcol0 = cs + 8 * quad;
    const int dcb = kcol0 - qcol + 15 + 16;
    unsigned vmask = 0;
#pragma unroll
    for (int j = 0; j < 8; ++j) { const int kc = kcol0 + j; if (kc >= lo && kc < lo + 16) vmask |= (1u << j); }
    const int keyl = cs + 8 * (q16 >> 2) + (q16 & 3), keyc = 8 * (q16 >> 2) + (q16 & 3);
    const unsigned ak0 = keyl * 128 + ((quad ^ swz_k(keyl)) * 16), ak1 = keyl * 128 + (((4 + quad) ^ swz_k(keyl)) * 16);
    const unsigned ck0 = keyc * 128 + ((quad ^ swz_k(keyc)) * 16), ck1 = keyc * 128 + (((4 + quad) ^ swz_k(keyc)) * 16);
    const unsigned av = q16 * 128 + ((((cs >> 3) + quad) ^ swz_v(q16)) * 16);
    const unsigned cv0 = q16 * 128 + ((quad ^ swz_v(q16)) * 16), cv1 = q16 * 128 + (((4 + quad) ^ swz_v(q16)) * 16);
    const int drow = wave * 8 + (lane >> 3), dsl = lane & 7;
    const size_t ksrc_off = (size_t)drow * HD + ((dsl ^ swz_k(drow)) * 8);
    const size_t vsrc_off = (size_t)drow * MTOT + ((dsl ^ swz_v(drow)) * 8);
#define A_ISSUE(seq_) do { const int _n = (seq_) / A_CH, _cj = (seq_) - _n * A_CH, _li = lb + _n * nb, _bh = 8 * x + (_li >> 4), _i0 = 2 * (_li & 15); \
        const int _b = _bh >> 3, _h = _bh & 7, _R0 = min(max(_i0 - 4, 0), 24); const int _slot = (seq_) % A_NS; \
        const bf16_t* _ks; const bf16_t* _vs; \
        if (_cj < 9) { const int _r = min(_R0 + _cj, 31); _ks = KR + ((size_t)_bh * SEQ + _r * 64) * HD + ksrc_off; _vs = VT + (size_t)(_h * HD) * MTOT + _b * SEQ + _r * 64 + vsrc_off; } \
        else { const int _c = _cj - 9; _ks = KC + ((size_t)_bh * CTXL + _c * 64) * HD + ksrc_off; _vs = VT + (size_t)(_h * HD) * MTOT + MLAT + _b * CTXL + _c * 64 + vsrc_off; } \
        glds16(_ks, (unsigned)__builtin_amdgcn_readfirstlane((int)(lds0 + A_RING + _slot * A_SLOT + wave * 1024))); \
        glds16(_vs, (unsigned)__builtin_amdgcn_readfirstlane((int)(lds0 + A_RING + _slot * A_SLOT + 8192 + wave * 1024))); } while (0)
#define A_LOADQ(n_) do { const int _li = lb + (n_) * nb, _bh = 8 * x + (_li >> 4), _i = 2 * (_li & 15) + ioff; \
        const size_t _qo = ((size_t)_bh * SEQ + _i * 64 + qcol) * HD + quad * 8; \
        qr0 = *(const bf16x8*)(QR + _qo); qr1 = *(const bf16x8*)(QR + _qo + 32); qp0 = *(const bf16x8*)(QP + _qo); qp1 = *(const bf16x8*)(QP + _qo + 32); } while (0)
#define A_LOADQ_ASYNC(n_) do { const int _li = lb + (n_) * nb, _bh = 8 * x + (_li >> 4), _i = 2 * (_li & 15) + ioff; \
        const size_t _qo = ((size_t)_bh * SEQ + _i * 64 + qcol) * HD + quad * 8; \
        gload16_async(qn0, QR + _qo); gload16_async(qn1, QR + _qo + 32); gload16_async(qn2, QP + _qo); gload16_async(qn3, QP + _qo + 32); } while (0)
    bf16x8 qr0, qr1, qp0, qp1;
    if (n_items > 0) A_LOADQ(0);
    for (int s = 0; s < A_D && s < total; ++s) A_ISSUE(s);
    f32x4 o[4]; float lsum = 0.f; u32x2 zz[4];
#pragma unroll
    for (int db = 0; db < 4; ++db) { o[db] = (f32x4){0.f, 0.f, 0.f, 0.f}; zz[db] = (u32x2){0u, 0u}; }
    int n = 0, cj = 0;
    for (int seq = 0; seq < total; ++seq) {
        const int rem = total - 1 - seq;
        if (rem >= 4) asm volatile("s_waitcnt vmcnt(8)" ::: "memory");
        else if (rem == 3) asm volatile("s_waitcnt vmcnt(6)" ::: "memory");
        else if (rem == 2) asm volatile("s_waitcnt vmcnt(4)" ::: "memory");
        else if (rem == 1) asm volatile("s_waitcnt vmcnt(2)" ::: "memory");
        else asm volatile("s_waitcnt vmcnt(0)" ::: "memory");
        __builtin_amdgcn_s_barrier();
        asm volatile("" ::: "memory");
        if (seq + A_D < total) A_ISSUE(seq + A_D);
        const int li = lb + n * nb, bh = 8 * x + (li >> 4), i0 = 2 * (li & 15), i = i0 + ioff, b = bh >> 3, h = bh & 7;
        const LAS unsigned char* kc = lds + A_RING + (seq % A_NS) * A_SLOT; const LAS unsigned char* vc = kc + 8192;
        if (cj < 9) {
            const int R0 = min(max(i0 - 4, 0), 24), rowu = R0 + cj, rsw = min(max(i - 4, 0), 24);
            if (rowu >= rsw && rowu < rsw + 8) {
                const int dr = rowu - i + 7;
                att_blk<true>(kc, ak0, ak1, vc, av, qr0, qr1, btab + (h * 15 + dr) * 64 + dcb, B2, vmask, o, lsum);
            }
        } else {
            if (cj == 9) {
                const size_t tokz = (size_t)b * SEQ + i * 64 + qcol;
#pragma unroll
                for (int db = 0; db < 4; ++db) zz[db] = *(const u32x2*)(ZA + tokz * 512 + h * HD + 16 * db + 4 * quad);
            }
            att_blk<false>(kc, ck0, ck1, vc, cv0, qp0, qp1, nullptr, B2, 0u, o, lsum);
            att_blk<false>(kc + 4096, ck0, ck1, vc, cv1, qp0, qp1, nullptr, B2, 0u, o, lsum);
        }
        if (++cj == A_CH) {
            lsum += __shfl_xor(lsum, 16); lsum += __shfl_xor(lsum, 32);
            const float inv = 1.0f / lsum;
            const size_t tok = (size_t)b * SEQ + i * 64 + qcol;
#pragma unroll
            for (int db = 0; db < 4; ++db) {
                const float z0 = __builtin_bit_cast(float, zz[db].x << 16), z1 = __builtin_bit_cast(float, zz[db].x & 0xffff0000u), z2 = __builtin_bit_cast(float, zz[db].y << 16), z3 = __builtin_bit_cast(float, zz[db].y & 0xffff0000u);
                u32x2 w; w.x = cvtpk(o[db][0] * inv * z0, o[db][1] * inv * z1); w.y = cvtpk(o[db][2] * inv * z2, o[db][3] * inv * z3);
                *(u32x2*)(MIXo + tok * DM + h * HD + 16 * db + 4 * quad) = w;
                o[db] = (f32x4){0.f, 0.f, 0.f, 0.f};
            }
            lsum = 0.f; cj = 0; ++n;
            if (n < n_items) A_LOADQ(n);
        }
    }
#undef A_ISSUE
#undef A_LOADQ
#undef A_LOADQ_ASYNC
    __syncthreads();
}
__device__ __forceinline__ void phase3_conv(const Params& p) {
    const int tid = threadIdx.x, G = gridDim.x;
    const bf16_t* CG = (const bf16_t*)(p.ws + WS_CG); bf16_t* MIX = (bf16_t*)(p.ws + WS_MIX);
    const int g = tid & 127, sub = tid >> 7;
    const f32x4 w0 = *(const f32x4*)(p.conv_w + 4 * g), w1 = *(const f32x4*)(p.conv_w + 512 + 4 * g), w2 = *(const f32x4*)(p.conv_w + 1024 + 4 * g), cb = *(const f32x4*)(p.conv_b + 4 * g);
#define LO16(u) __builtin_bit_cast(float, (u) << 16)
#define HI16(u) __builtin_bit_cast(float, (u) & 0xffff0000u)
    for (int chunk = blockIdx.x; chunk < MLAT / 32; chunk += G) {
        const int tok0 = chunk * 32 + sub * 8, t0 = tok0 & (SEQ - 1);
        const bf16_t* src = CG + (size_t)tok0 * 1024 + g * 8;
        u32x4 cur[8]; u32x2 pv = {0u, 0u}, nv = {0u, 0u};
#pragma unroll
        for (int k = 0; k < 8; ++k) cur[k] = *(const u32x4*)(src + (size_t)k * 1024);
        if (t0 > 0) pv = *(const u32x2*)(src - 1024);
        if (t0 + 8 < SEQ) nv = *(const u32x2*)(src + 8 * 1024);
        f32x4 cprev = {LO16(pv.x), HI16(pv.x), LO16(pv.y), HI16(pv.y)};
        f32x4 cc = {LO16(cur[0].x), HI16(cur[0].x), LO16(cur[0].y), HI16(cur[0].y)};
#pragma unroll
        for (int k = 0; k < 8; ++k) {
            const u32x2 nx = (k < 7) ? (u32x2){cur[k < 7 ? k + 1 : 7].x, cur[k < 7 ? k + 1 : 7].y} : nv;
            const f32x4 cn = {LO16(nx.x), HI16(nx.x), LO16(nx.y), HI16(nx.y)};
            const f32x4 gz = {LO16(cur[k].z), HI16(cur[k].z), LO16(cur[k].w), HI16(cur[k].w)};
            const f32x4 y = gz * (cb + w0 * cprev + w1 * cc + w2 * cn);
            u32x2 w; w.x = cvtpk(y[0], y[1]); w.y = cvtpk(y[2], y[3]);
            *(u32x2*)(MIX + (size_t)(tok0 + k) * DM + 512 + 4 * g) = w;
            cprev = cc; cc = cn;
        }
    }
#undef LO16
#undef HI16
}

#define XB_TMO      128
#define XB_XCNT(j)  (256  + 64 * (j))
#define XB_XSUB(j)  (1280 + 64 * (j))
#define XB_XGEN(j)  (2304 + 64 * (j))
#define XB_TOP      3328
#define XB_TOPGEN   3392
#define XCD_BAR_WORDS 3456
#define XB_SPIN_CAP (1u << 18)
__device__ __forceinline__ unsigned xb_ld(unsigned* p)              { return __hip_atomic_load(p, __ATOMIC_RELAXED, __HIP_MEMORY_SCOPE_AGENT); }
__device__ __forceinline__ unsigned xb_add(unsigned* p, unsigned v) { return __hip_atomic_fetch_add(p, v, __ATOMIC_RELAXED, __HIP_MEMORY_SCOPE_AGENT); }
__device__ __forceinline__ unsigned xb_xcc_id() { return (unsigned)__builtin_amdgcn_s_getreg((3 << 11) | 20) & 0xFu; }
#define XB_SPIN(cond, bar) do { unsigned _sp = 0; while (cond) { __builtin_amdgcn_s_sleep(1); \
    if ((++_sp & 255u) == 0u) { if (xb_ld(&(bar)[XB_TMO])) break; if (_sp > XB_SPIN_CAP) { atomicAdd(&(bar)[XB_TMO], 1u); break; } } } } while (0)
struct XcdBarrier { unsigned* bar; unsigned x; volatile LAS unsigned* st; };
__device__ __forceinline__ XcdBarrier xcd_barrier_post(unsigned* bar, volatile LAS unsigned* st) {
    XcdBarrier b; b.bar = bar; b.x = xb_xcc_id(); b.st = st;
    if (threadIdx.x == 0) (void)xb_add(&bar[XB_XCNT(b.x)], 1u);
    return b;
}
__device__ __forceinline__ void xcd_barrier_complete(unsigned* bar, unsigned x, unsigned& nloc, unsigned& nx) {
    const unsigned G = gridDim.x * gridDim.y * gridDim.z;
    unsigned sum, cnt, mine, sp = 0u;
    for (;;) {
        sum = 0u; cnt = 0u; mine = 0u;
#pragma unroll
        for (unsigned j = 0; j < 16; ++j) { const unsigned c = xb_ld(&bar[XB_XCNT(j)]); sum += c; cnt += (c > 0u) ? 1u : 0u; mine = (j == x) ? c : mine; }
        if (sum == G) break;
        __builtin_amdgcn_s_sleep(1);
        if ((++sp & 255u) == 0u) { if (xb_ld(&bar[XB_TMO])) break; if (sp > XB_SPIN_CAP) { atomicAdd(&bar[XB_TMO], 1u); break; } }
    }
    nloc = mine > 0u ? mine : 1u; nx = cnt > 0u ? cnt : 1u;
}
__device__ __forceinline__ void xcd_barrier(const XcdBarrier& b) {
    asm volatile("s_waitcnt vmcnt(0)" ::: "memory");
    __syncthreads();
    if (threadIdx.x == 0) {
        unsigned* bar = b.bar;
        __builtin_amdgcn_s_waitcnt(0);
        unsigned nloc = b.st[0], nx = b.st[1];
        if (nloc == 0u) { xcd_barrier_complete(bar, b.x, nloc, nx); b.st[0] = nloc; b.st[1] = nx; }
        const unsigned old = xb_add(&bar[XB_XSUB(b.x)], 1u);
        const unsigned gen = old / nloc;
        if (old + 1u == (gen + 1u) * nloc) {
            __builtin_amdgcn_fence(__ATOMIC_RELEASE, "agent");
            asm volatile("s_waitcnt vmcnt(0)" ::: "memory");
            const unsigned og = xb_add(&bar[XB_TOP], 1u);
            const unsigned tg = og / nx;
            if (og + 1u == (tg + 1u) * nx) xb_add(&bar[XB_TOPGEN], 1u);
            else XB_SPIN(xb_ld(&bar[XB_TOPGEN]) == tg, bar);
            __builtin_amdgcn_fence(__ATOMIC_ACQUIRE, "agent");
            xb_add(&bar[XB_XGEN(b.x)], 1u);
            asm volatile("s_waitcnt vmcnt(0)" ::: "memory");
        } else {
            XB_SPIN(xb_ld(&bar[XB_XGEN(b.x)]) == gen, bar);
            __builtin_amdgcn_fence(__ATOMIC_ACQUIRE, "agent");
            asm volatile("s_waitcnt vmcnt(0)" ::: "memory");
        }
    }
    __syncthreads();
}

__global__ void __launch_bounds__(NTHREADS, 2) fwd_megakernel(Params p) {
    extern __shared__ __attribute__((aligned(16))) unsigned char lds_raw[];
    LAS unsigned char* lds = (LAS unsigned char*)lds_raw;
    cg::grid_group grid = cg::this_grid();
    if (threadIdx.x < 16) ((LAS unsigned*)(lds + LDS_MISC))[threadIdx.x] = 0u;
    __syncthreads();
    XcdBarrier xbar = xcd_barrier_post((unsigned*)(p.ws + WS_BAR), (volatile LAS unsigned*)(lds + LDS_MISC));
    if (p.ph_lo < 0) grid.sync();
#define GSYNC() xcd_barrier(xbar)
    const int lo = p.ph_lo, hi = p.ph_hi;
    const int x = blockIdx.x & 7, lb = blockIdx.x >> 3, nb = gridDim.x >> 3;
    EpiCtx E;
    E.QP = (bf16_t*)(p.ws + WS_QP); E.QR = (bf16_t*)(p.ws + WS_QR); E.KR = (bf16_t*)(p.ws + WS_KR); E.KC = (bf16_t*)(p.ws + WS_KC);
    E.VT = (bf16_t*)(p.ws + WS_VT); E.ZA = (bf16_t*)(p.ws + WS_ZA); E.CG = (bf16_t*)(p.ws + WS_CG);
    E.gq = p.q_norm_g; E.gk = p.k_norm_g; E.rope = (const float*)(p.ws + WS_ROPE);
    E.x = p.x; E.gate = (const float*)(p.ws + WS_GATE); E.out = p.out;
#define IN(k) (lo <= (k) && (k) < hi)
#define SEAM(k) do { if (IN(k) && IN((k) + 1)) GSYNC(); } while (0)
#define REP(k, ...) do { if (IN(k)) { __VA_ARGS__; if (PROBE_REP == (k)) { GSYNC(); __VA_ARGS__; } } } while (0)
    REP(0, phase0(p, lds));
    SEAM(0);
    REP(1, phase1(p, lds));
    SEAM(1);
    REP(2, { SchedP2 S{x, lb, nb, (const char*)(p.ws + WS_XN), (const char*)(p.ws + WS_WT)}; gemm_phase<2>(lds, S, E); });
    SEAM(2);
    REP(3, phase3(p, lds));
    if (IN(3)) { phase3_conv(p); if (PROBE_REP == 31) { GSYNC(); phase3_conv(p); } }
    SEAM(3);
    REP(4, { SchedP4 S{x, lb, nb, (const char*)(p.ws + WS_MIX), (const char*)(p.ws + WS_WO)}; gemm_phase<4>(lds, S, E); });
#undef REP
    if (PROBE_REP == 99) { GSYNC(); GSYNC(); GSYNC(); GSYNC(); }
#undef IN
#undef SEAM
}

extern "C" void kernel_launch(void* const* d_in, const int* in_sizes, int n_in, void* d_out, int out_size, void* d_ws, size_t ws_size, hipStream_t stream) {
    static int grid = 0;
    if (grid == 0) {
        int dev = 0, cus = 0, per_cu = 0;
        hipGetDevice(&dev);
        hipDeviceGetAttribute(&cus, hipDeviceAttributeMultiprocessorCount, dev);
        if (hipFuncSetAttribute((const void*)fwd_megakernel, hipFuncAttributeMaxDynamicSharedMemorySize, LDS_BYTES) != hipSuccess) { fprintf(stderr, "hipFuncSetAttribute failed\n"); grid = -1; return; }
        hipOccupancyMaxActiveBlocksPerMultiprocessor(&per_cu, (const void*)fwd_megakernel, NTHREADS, LDS_BYTES);
        if (per_cu < 1) { fprintf(stderr, "occupancy query says %d blocks per CU\n", per_cu); grid = -1; return; }
        grid = cus;
        grid -= grid % 8;
        if (n_in != 14 || ws_size < WS_END || grid < 8) { fprintf(stderr, "unexpected problem geometry\n"); grid = -1; return; }
    }
    if (grid < 0) return;
    Params p{};
    p.x = (const float*)d_in[0]; p.c = (const float*)d_in[1]; p.ctx = (const float*)d_in[2]; p.c_ctx = (const float*)d_in[3];
    p.w_ada = (const float*)d_in[4]; p.b_ada = (const float*)d_in[5]; p.norm_g = (const float*)d_in[6]; p.w_in = (const float*)d_in[7];
    p.q_norm_g = (const float*)d_in[8]; p.k_norm_g = (const float*)d_in[9]; p.rpb = (const float*)d_in[10]; p.conv_w = (const float*)d_in[11];
    p.conv_b = (const float*)d_in[12]; p.w_out = (const float*)d_in[13];
    p.out = (float*)d_out; p.ws = (unsigned char*)d_ws;
    if (hipMemsetAsync((char*)d_ws + WS_BAR, 0, BAR_BYTES, stream) != hipSuccess) { fprintf(stderr, "memset of barrier words failed\n"); return; }
#if N_LAUNCH_MODE == 1
    p.ph_lo = 0; p.ph_hi = 5;
    void* args[] = {&p};
    hipError_t e = hipLaunchCooperativeKernel((const void*)fwd_megakernel, dim3(grid), dim3(NTHREADS), args, LDS_BYTES, stream);
    if (e != hipSuccess) fprintf(stderr, "cooperative launch failed: %s (grid %d)\n", hipGetErrorString(e), grid);
#else
    for (int ph = 0; ph < 5; ++ph) {
        p.ph_lo = ph; p.ph_hi = ph + 1;
        hipLaunchKernelGGL(fwd_megakernel, dim3(grid), dim3(NTHREADS), LDS_BYTES, stream, p);
    }
#endif
}
```

```cpp
#include <hip/hip_runtime.h>
#include <hip/hip_cooperative_groups.h>
#include <cstdio>
#include <cstdint>
namespace cg = cooperative_groups;

#ifndef N_LAUNCH_MODE
#define N_LAUNCH_MODE 1
#endif

#ifndef PROBE_REP
#define PROBE_REP -1
#endif

#define LAS __attribute__((address_space(3)))
typedef unsigned short bf16_t;
typedef short bf16x8 __attribute__((ext_vector_type(8)));
typedef float f32x4 __attribute__((ext_vector_type(4)));
typedef float f32x2 __attribute__((ext_vector_type(2)));
typedef unsigned u32x4 __attribute__((ext_vector_type(4)));
typedef unsigned u32x2 __attribute__((ext_vector_type(2)));
typedef __bf16 bf16x2_t __attribute__((ext_vector_type(2)));

constexpr int NBATCH = 8, SEQ = 2048, DM = 1024, CTXL = 256, NH = 8, HD = 64;
constexpr int MLAT = NBATCH * SEQ, MCTX = NBATCH * CTXL, MTOT = MLAT + MCTX;
constexpr int DIN = 4096, NADA = 3072;
constexpr float RMS_EPS = 1e-6f;
constexpr float LOG2E = 1.4426950408889634f;

constexpr size_t MiB = 1u << 20;
constexpr size_t WS_WT = 0;
constexpr size_t WS_WO = 8 * MiB;
constexpr size_t WS_ADAP = 196 * MiB;
constexpr size_t WS_GATE = 11 * MiB;
constexpr size_t WS_ROPE = 11 * MiB + 65536;
constexpr size_t WS_BND = 11 * MiB + 131072;
constexpr size_t WS_BAR = 11 * MiB + 262144;
constexpr size_t BAR_BYTES = 16384;
constexpr int LDS_MISC = 147456 - 64;
constexpr size_t WS_XN = 12 * MiB;
constexpr size_t WS_QP = 48 * MiB;
constexpr size_t WS_QR = 64 * MiB;
constexpr size_t WS_KR = 80 * MiB;
constexpr size_t WS_KC = 96 * MiB;
constexpr size_t WS_VT = 98 * MiB;
constexpr size_t WS_ZA = 116 * MiB;
constexpr size_t WS_CG = 132 * MiB;
constexpr size_t WS_MIX = 164 * MiB;
constexpr size_t WS_END = 198 * MiB;

constexpr int LDS_BYTES = 147456;
constexpr int NTHREADS = 512;

struct Params {
    const float *x, *c, *ctx, *c_ctx, *w_ada, *b_ada, *norm_g, *w_in, *q_norm_g, *k_norm_g, *rpb, *conv_w, *conv_b, *w_out;
    float* out; unsigned char* ws; int ph_lo, ph_hi;
};

__device__ __forceinline__ unsigned cvtpk(float lo, float hi) { f32x2 v = {lo, hi}; bf16x2_t b = __builtin_convertvector(v, bf16x2_t); return __builtin_bit_cast(unsigned, b); }
__device__ __forceinline__ float bf2f(unsigned short h) { return __builtin_bit_cast(float, (unsigned)h << 16); }
__device__ __forceinline__ float silu_f(float v) { return v * __builtin_amdgcn_rcpf(1.0f + __builtin_amdgcn_exp2f(-v * LOG2E)); }
__device__ __forceinline__ float wave_sum(float v) {
#pragma unroll
    for (int o = 1; o < 64; o <<= 1) v += __shfl_xor(v, o);
    return v;
}

constexpr int BM = 256, BK = 64, HALF = 128, HTB = HALF * BK * 2, KDIM = 1024;
constexpr size_t TSTEP = (size_t)BM * KDIM * 2;
__device__ __forceinline__ int lds_byte(int r, int c) { const int st = (r >> 4) * 2 + (c >> 5), rr = r & 15, cc = c & 31, ob = rr * 64 + cc * 2; return st * 1024 + (ob ^ (((ob >> 9) & 1) << 5)); }
__device__ __forceinline__ void stage_rc(int b, int& R, int& C) { const int st = b / 1024, sb = b % 1024, swz = sb ^ (((sb >> 9) & 1) << 5); R = (st >> 1) * 16 + swz / 64; C = (st & 1) * 32 + (swz % 64) / 2; }
__device__ __forceinline__ int perm32(int rho) { const int n = rho >> 4, i = rho & 15; return 8 * (i >> 2) + 4 * n + (i & 3); }

struct Unit { const char* a; const char* b; int kind, pm, pn; };

struct EpiCtx {
    bf16_t *QP, *QR, *KR, *KC, *VT, *ZA, *CG;
    const float *gq, *gk, *rope;
    const float *x, *gate; float* out;
};

template <int PH>
__device__ __forceinline__ void epilogue(const f32x4 (&acc)[2][2][4][2], const Unit& u, int wr, int wc, int fr, int fq, const EpiCtx& E) {
    if constexpr (PH == 4) {
        const int b = (u.pm * BM) >> 11;
        const int c0 = u.pn * BM + wc * 32 + fq * 8;
        f32x4 gv[2][2];
#pragma unroll
        for (int bj = 0; bj < 2; ++bj)
#pragma unroll
            for (int n = 0; n < 2; ++n) gv[bj][n] = *(const f32x4*)(E.gate + b * DM + c0 + bj * HALF + 4 * n);
        const float* __restrict__ xp = E.x; float* __restrict__ op = E.out;
#pragma unroll
        for (int ai = 0; ai < 2; ++ai)
#pragma unroll
            for (int mp = 0; mp < 2; ++mp) {
                f32x4 xv[2][2][2];
#pragma unroll
                for (int mm = 0; mm < 2; ++mm) {
                    const size_t off = (size_t)(u.pm * BM + ai * HALF + wr * 64 + (2 * mp + mm) * 16 + fr) * DM + c0;
#pragma unroll
                    for (int bj = 0; bj < 2; ++bj)
#pragma unroll
                        for (int n = 0; n < 2; ++n) xv[mm][bj][n] = __builtin_nontemporal_load((const f32x4*)(xp + off + bj * HALF + 4 * n));
                }
#pragma unroll
                for (int mm = 0; mm < 2; ++mm) {
                    const size_t off = (size_t)(u.pm * BM + ai * HALF + wr * 64 + (2 * mp + mm) * 16 + fr) * DM + c0;
#pragma unroll
                    for (int bj = 0; bj < 2; ++bj)
#pragma unroll
                        for (int n = 0; n < 2; ++n) __builtin_nontemporal_store(xv[mm][bj][n] + gv[bj][n] * acc[ai][bj][2 * mp + mm][n], (f32x4*)(op + off + bj * HALF + 4 * n));
                }
            }
    } else {
        const int kind = u.kind;
        if (kind == 0 || kind == 1 || kind == 5) {
            const bool isq = (kind == 0);
            const float* g = isq ? E.gq : E.gk;
            const float qs = isq ? 0.125f * LOG2E : 1.0f;
            const int head = 4 * (u.pn & 1) + wc;
            f32x4 gv[2][2];
#pragma unroll
            for (int bj = 0; bj < 2; ++bj)
#pragma unroll
                for (int n = 0; n < 2; ++n) gv[bj][n] = *(const f32x4*)(g + 32 * bj + 16 * n + 4 * fq);
#pragma unroll
            for (int ai = 0; ai < 2; ++ai)
#pragma unroll
                for (int m = 0; m < 4; ++m) {
                    const int r = u.pm * BM + ai * HALF + wr * 64 + m * 16 + fr;
                    f32x4 v[2][2]; float ss = 0.f;
#pragma unroll
                    for (int bj = 0; bj < 2; ++bj)
#pragma unroll
                        for (int n = 0; n < 2; ++n) { v[bj][n] = acc[ai][bj][m][n]; const f32x4 t = v[bj][n] * v[bj][n]; ss += (t[0] + t[1]) + (t[2] + t[3]); }
                    ss += __shfl_xor(ss, 16); ss += __shfl_xor(ss, 32);
                    const float rinv = __builtin_amdgcn_rsqf(ss * (1.0f / 64.0f) + RMS_EPS) * qs;
#pragma unroll
                    for (int bj = 0; bj < 2; ++bj)
#pragma unroll
                        for (int n = 0; n < 2; ++n) v[bj][n] = v[bj][n] * rinv * gv[bj][n];
                    if (kind == 5) {
                        const int rc = r - MLAT, b = rc >> 8, l = rc & 255;
                        bf16_t* dst = E.KC + ((size_t)((b * NH + head) * CTXL + l)) * HD + fq * 16;
#pragma unroll
                        for (int bj = 0; bj < 2; ++bj) { u32x4 w; w.x = cvtpk(v[bj][0][0], v[bj][0][1]); w.y = cvtpk(v[bj][0][2], v[bj][0][3]); w.z = cvtpk(v[bj][1][0], v[bj][1][1]); w.w = cvtpk(v[bj][1][2], v[bj][1][3]); *(u32x4*)(dst + bj * 8) = w; }
                    } else {
                        const int b = r >> 11, t = r & 2047, grow = t >> 6, gcol = t & 63;
                        const size_t rowoff = ((size_t)((b * NH + head) * SEQ + t)) * HD + fq * 16;
                        if (isq) {
                            bf16_t* dst = E.QP + rowoff;
#pragma unroll
                            for (int bj = 0; bj < 2; ++bj) { u32x4 w; w.x = cvtpk(v[bj][0][0], v[bj][0][1]); w.y = cvtpk(v[bj][0][2], v[bj][0][3]); w.z = cvtpk(v[bj][1][0], v[bj][1][1]); w.w = cvtpk(v[bj][1][2], v[bj][1][3]); *(u32x4*)(dst + bj * 8) = w; }
                        }
                        bf16_t* dst = (isq ? E.QR : E.KR) + rowoff;
#pragma unroll
                        for (int bj = 0; bj < 2; ++bj) {
                            const int pos = bj ? gcol : grow;
                            const f32x4 cs = *(const f32x4*)(E.rope + pos * 16 + 4 * fq), sn = *(const f32x4*)(E.rope + 1024 + pos * 16 + 4 * fq);
                            const f32x4 o0 = v[bj][0] * cs - v[bj][1] * sn, o1 = v[bj][1] * cs + v[bj][0] * sn;
                            u32x4 w; w.x = cvtpk(o0[0], o0[1]); w.y = cvtpk(o0[2], o0[3]); w.z = cvtpk(o1[0], o1[1]); w.w = cvtpk(o1[2], o1[3]);
                            *(u32x4*)(dst + bj * 8) = w;
                        }
                    }
                }
        } else if (kind == 2) {
            const int c0 = (u.pn - 6) * BM + wc * 32 + fq * 8;
#pragma unroll
            for (int ai = 0; ai < 2; ++ai)
#pragma unroll
                for (int m = 0; m < 4; ++m) {
                    bf16_t* dst = E.ZA + (size_t)(u.pm * BM + ai * HALF + wr * 64 + m * 16 + fr) * 512 + c0;
#pragma unroll
                    for (int bj = 0; bj < 2; ++bj) {
                        const f32x4 a0 = acc[ai][bj][m][0], a1 = acc[ai][bj][m][1];
                        u32x4 w; w.x = cvtpk(silu_f(a0[0]), silu_f(a0[1])); w.y = cvtpk(silu_f(a0[2]), silu_f(a0[3])); w.z = cvtpk(silu_f(a1[0]), silu_f(a1[1])); w.w = cvtpk(silu_f(a1[2]), silu_f(a1[3]));
                        *(u32x4*)(dst + bj * HALF) = w;
                    }
                }
        } else if (kind == 3) {
            const int ch0 = (u.pn - 8) * 64 + wc * 16 + fq * 4;
#pragma unroll
            for (int ai = 0; ai < 2; ++ai)
#pragma unroll
                for (int m = 0; m < 4; ++m) {
                    const f32x4 uu = acc[ai][0][m][0], bg = acc[ai][0][m][1], cgv = acc[ai][1][m][0], zc = acc[ai][1][m][1];
                    const f32x4 cu = cgv * uu;
                    f32x4 gz;
#pragma unroll
                    for (int j = 0; j < 4; ++j) gz[j] = bg[j] * silu_f(zc[j]);
                    u32x4 w; w.x = cvtpk(cu[0], cu[1]); w.y = cvtpk(cu[2], cu[3]); w.z = cvtpk(gz[0], gz[1]); w.w = cvtpk(gz[2], gz[3]);
                    *(u32x4*)(E.CG + (size_t)(u.pm * BM + ai * HALF + wr * 64 + m * 16 + fr) * 1024 + ch0 * 2) = w;
                }
        } else {
            const int c0 = u.pn * BM + wc * 32 + fq * 8;
#pragma unroll
            for (int ai = 0; ai < 2; ++ai)
#pragma unroll
                for (int m = 0; m < 4; ++m) {
                    bf16_t* dst = E.VT + (size_t)(u.pm * BM + ai * HALF + wr * 64 + m * 16 + fr) * MTOT + c0;
#pragma unroll
                    for (int bj = 0; bj < 2; ++bj) {
                        const f32x4 a0 = acc[ai][bj][m][0], a1 = acc[ai][bj][m][1];
                        u32x4 w; w.x = cvtpk(a0[0], a0[1]); w.y = cvtpk(a0[2], a0[3]); w.z = cvtpk(a1[0], a1[1]); w.w = cvtpk(a1[2], a1[3]);
                        *(u32x4*)(dst + bj * HALF) = w;
                    }
                }
        }
    }
}

struct SchedP2 {
    int x, lb, nb; const char* XN; const char* WT;
    __device__ __forceinline__ bool next(int i, Unit& u) const {
        const int uu = lb + i * nb; if (uu >= 132) return false;
        if (uu < 112) {
            const int pi = uu >> 3, pm = 8 * x + (uu & 7), pn = pi < 4 ? pi : pi + 2;
            u.kind = pn < 2 ? 0 : (pn < 4 ? 1 : (pn < 8 ? 2 : 3)); u.pm = pm; u.pn = pn; u.a = XN + (size_t)pm * TSTEP; u.b = WT + (size_t)pn * TSTEP;
        } else if (uu < 130) {
            const int v = uu - 112, pnp = 9 * x + v % 9, pmp = v / 9;
            u.kind = 4; u.pm = pmp; u.pn = pnp; u.a = WT + (size_t)(4 + pmp) * TSTEP; u.b = XN + (size_t)pnp * TSTEP;
        } else {
            u.kind = 5; u.pm = 64 + x; u.pn = 2 + (uu - 130); u.a = XN + (size_t)u.pm * TSTEP; u.b = WT + (size_t)u.pn * TSTEP;
        }
        return true;
    }
};
struct SchedP4 {
    int x, lb, nb; const char* MIX; const char* WO;
    __device__ __forceinline__ bool next(int i, Unit& u) const {
        const int uu = lb + i * nb; if (uu >= 32) return false;
        u.kind = 6; u.pm = 8 * x + (uu & 7); u.pn = uu >> 3; u.a = MIX + (size_t)u.pm * TSTEP; u.b = WO + (size_t)u.pn * TSTEP; return true;
    }
};

template <int PH, class Sched>
__device__ __forceinline__ void gemm_phase(LAS unsigned char* lds, const Sched& S, const EpiCtx& E) {
    const int tid = threadIdx.x, wid = __builtin_amdgcn_readfirstlane(tid >> 6), lane = tid & 63, wr = wid >> 2, wc = wid & 3, fr = lane & 15, fq = lane >> 4;
    constexpr int K = KDIM, nt = K / BK;
    unsigned voffA[2], voffB[2];
#pragma unroll
    for (int i = 0; i < 2; ++i) { int R, C; stage_rc(tid * 16 + i * 8192, R, C); const int Rb = (R & ~31) + perm32(R & 31);
        voffA[i] = (unsigned)(R * K + C) * 2u; voffB[i] = (unsigned)(Rb * K + C) * 2u; }
    const size_t kstep = (size_t)(BK * 2);
    const size_t hstep = (size_t)HALF * K * 2;
    const unsigned ldsw = (unsigned)wid * 1024u;
    const int aoff = lds_byte(wr * 64 + fr, fq * 8), boff = lds_byte(wc * 32 + fr, fq * 8);
#define PG8_SA(b, h) (((b) * 2 + (h)) * HTB)
#define PG8_SB(b, h) ((4 + (b) * 2 + (h)) * HTB)
#define PG8_STAGE(bufoff, gbase, voff) do { _Pragma("unroll") for (int _i = 0; _i < 2; ++_i) \
        __builtin_amdgcn_global_load_lds((const unsigned*)((const char*)(gbase) + (voff)[_i]), (LAS unsigned*)(lds + (bufoff) + ldsw + _i * 8192), 16, 0, 0); } while (0)
#define PG8_LDA(dst, b, h) do { _Pragma("unroll") for (int m = 0; m < 4; ++m) _Pragma("unroll") for (int k = 0; k < 2; ++k) dst[m][k] = *(const LAS bf16x8*)(lds + PG8_SA(b, h) + aoff + m * 2048 + k * 1024); } while (0)
#define PG8_LDB(dst, b, h) do { _Pragma("unroll") for (int n = 0; n < 2; ++n) _Pragma("unroll") for (int k = 0; k < 2; ++k) dst[n][k] = *(const LAS bf16x8*)(lds + PG8_SB(b, h) + boff + n * 2048 + k * 1024); } while (0)
#define PG8_MMA(ai, bj, At, Bt) do { __builtin_amdgcn_s_setprio(1); _Pragma("unroll") for (int m = 0; m < 4; ++m) _Pragma("unroll") for (int n = 0; n < 2; ++n) _Pragma("unroll") for (int k = 0; k < 2; ++k) \
        acc[ai][bj][m][n] = __builtin_amdgcn_mfma_f32_16x16x32_bf16(Bt[n][k], At[m][k], acc[ai][bj][m][n], 0, 0, 0); __builtin_amdgcn_s_setprio(0); } while (0)
#define PG8_WAIT_V(n) asm volatile("s_waitcnt vmcnt(" #n ")" ::: "memory")
#define PG8_WAIT_L(n) asm volatile("s_waitcnt lgkmcnt(" #n ")" ::: "memory")
#define PG8_BAR __builtin_amdgcn_s_barrier()
#define PG8_SCHED __builtin_amdgcn_sched_barrier(0)
    Unit cur, nxt; int ui = 0;
    if (!S.next(0, cur)) return;
    f32x4 acc[2][2][4][2];
#pragma unroll
    for (int a = 0; a < 2; ++a)
#pragma unroll
        for (int b = 0; b < 2; ++b)
#pragma unroll
            for (int m = 0; m < 4; ++m)
#pragma unroll
                for (int n = 0; n < 2; ++n) acc[a][b][m][n] = (f32x4){0.f, 0.f, 0.f, 0.f};
    bf16x8 At[4][2], B0[2][2], B1[2][2];
    const char* cA = cur.a; const char* cB = cur.b;
    PG8_STAGE(PG8_SB(0, 0), cB, voffB); PG8_STAGE(PG8_SB(0, 1), cB + hstep, voffB); PG8_STAGE(PG8_SA(0, 0), cA, voffA); PG8_STAGE(PG8_SA(0, 1), cA + hstep, voffA);
    if (wr == 1) PG8_BAR;
    PG8_WAIT_V(2); PG8_BAR;
    PG8_STAGE(PG8_SB(1, 0), cB + kstep, voffB); PG8_STAGE(PG8_SA(1, 0), cA + kstep, voffA); PG8_STAGE(PG8_SB(1, 1), cB + hstep + kstep, voffB);
    PG8_WAIT_V(6); PG8_BAR;
    for (;;) {
        const bool has_next = S.next(ui + 1, nxt);
        const char* nA = has_next ? nxt.a : cA; const char* nB = has_next ? nxt.b : cB;
        for (int t = 0; t < nt; t += 2) {
            const bool last = (t == nt - 2);
            const char* a1 = cA + (size_t)(t + 1) * kstep;
            const char* a2 = last ? nA : cA + (size_t)(t + 2) * kstep; const char* b2 = last ? nB : cB + (size_t)(t + 2) * kstep;
            const char* a3 = a2 + kstep; const char* b3 = b2 + kstep;
            PG8_LDB(B0, 0, 0); PG8_LDB(B1, 0, 1); PG8_SCHED; PG8_LDA(At, 0, 0); PG8_STAGE(PG8_SA(1, 1), a1 + hstep, voffA);
            PG8_WAIT_V(8); PG8_WAIT_L(0); PG8_BAR; PG8_MMA(0, 0, At, B0); PG8_MMA(0, 1, At, B1); PG8_BAR; PG8_SCHED;
            PG8_LDA(At, 0, 1); PG8_STAGE(PG8_SB(0, 0), b2, voffB); PG8_STAGE(PG8_SB(0, 1), b2 + hstep, voffB); PG8_STAGE(PG8_SA(0, 0), a2, voffA);
            PG8_WAIT_V(8); PG8_WAIT_L(0); PG8_BAR; PG8_MMA(1, 0, At, B0); PG8_MMA(1, 1, At, B1); PG8_BAR; PG8_SCHED;
            PG8_LDB(B0, 1, 0); PG8_LDB(B1, 1, 1); PG8_SCHED; PG8_LDA(At, 1, 0); PG8_STAGE(PG8_SA(0, 1), a2 + hstep, voffA);
            PG8_WAIT_V(8); PG8_WAIT_L(0); PG8_BAR; PG8_MMA(0, 0, At, B0); PG8_MMA(0, 1, At, B1); PG8_BAR; PG8_SCHED;
            PG8_LDA(At, 1, 1); PG8_STAGE(PG8_SB(1, 0), b3, voffB); PG8_STAGE(PG8_SB(1, 1), b3 + hstep, voffB); PG8_STAGE(PG8_SA(1, 0), a3, voffA);
            PG8_WAIT_V(8); PG8_WAIT_L(0); PG8_BAR; PG8_MMA(1, 0, At, B0); PG8_MMA(1, 1, At, B1); PG8_BAR; PG8_SCHED;
        }
        if (wr == 0) PG8_BAR;
        epilogue<PH>(acc, cur, wr, wc, fr, fq, E);
        if (!has_next) break;
#pragma unroll
        for (int a = 0; a < 2; ++a)
#pragma unroll
            for (int b = 0; b < 2; ++b)
#pragma unroll
                for (int m = 0; m < 4; ++m)
#pragma unroll
                    for (int n = 0; n < 2; ++n) acc[a][b][m][n] = (f32x4){0.f, 0.f, 0.f, 0.f};
        cur = nxt; cA = nA; cB = nB; ++ui;
        if (wr == 1) PG8_BAR;
    }
    PG8_WAIT_V(0);
    PG8_BAR;
#undef PG8_SA
#undef PG8_SB
#undef PG8_STAGE
#undef PG8_LDA
#undef PG8_LDB
#undef PG8_MMA
#undef PG8_WAIT_V
#undef PG8_WAIT_L
#undef PG8_BAR
#undef PG8_SCHED
}

__device__ __forceinline__ int wt_dst_row(int c) {
    if (c < 1024) {
        const int base = c & ~511, local = c & 511, head = local >> 6, d = local & 63;
        const int pnl = head >> 2, wc = head & 3, bj = d >> 5, n = (d >> 4) & 1, f = d & 15, fq = f >> 2, j = f & 3;
        return base + pnl * 256 + 128 * bj + 32 * wc + 8 * fq + 4 * n + j;
    } else if (c < 2048) {
        return c;
    } else {
        const int type = (c - 2048) >> 9, ch = (c - 2048) & 511, ct = ch >> 6, chl = ch & 63;
        const int wc = chl >> 4, fq = (chl >> 2) & 3, j = chl & 3, bj = type >> 1, n = type & 1;
        return 2048 + ct * 256 + 128 * bj + 32 * wc + 8 * fq + 4 * n + j;
    }
}
template <bool PERMUTE>
__device__ __forceinline__ void p0_transpose_item(const float* W, int N, bf16_t* WT, LAS float* scr, int item, int lane) {
    const int nblk = N / 32, kb = item / nblk, nb = item % nblk, k0 = 64 * kb, n0 = 32 * nb;
    const int loff = (lane >> 5) * N + (lane & 31);
#pragma unroll
    for (int hh = 0; hh < 2; ++hh) {
        float tv[16];
#pragma unroll
        for (int i = 0; i < 16; ++i) { const float* wu = W + (size_t)(k0 + 2 * (16 * hh + i)) * N + n0; tv[i] = wu[loff]; }
#pragma unroll
        for (int i = 0; i < 16; ++i) scr[(2 * (16 * hh + i) + (lane >> 5)) * 33 + (lane & 31)] = tv[i];
    }
    asm volatile("s_waitcnt lgkmcnt(0)" ::: "memory");
    const int c = lane & 7;
#pragma unroll
    for (int j = 0; j < 4; ++j) { const int n = (lane >> 3) + 8 * j; const LAS float* s = scr + (8 * c) * 33 + n;
        u32x4 o; o.x = cvtpk(s[0 * 33], s[1 * 33]); o.y = cvtpk(s[2 * 33], s[3 * 33]); o.z = cvtpk(s[4 * 33], s[5 * 33]); o.w = cvtpk(s[6 * 33], s[7 * 33]);
        const int drow = PERMUTE ? wt_dst_row(n0 + n) : (n0 + n);
        *(u32x4*)(WT + (size_t)drow * KDIM + k0 + 8 * c) = o; }
    asm volatile("s_waitcnt lgkmcnt(0)" ::: "memory");
}

__device__ __forceinline__ void phase0(const Params& p, LAS unsigned char* lds) {
    const int tid = threadIdx.x, lane = tid & 63, wave = __builtin_amdgcn_readfirstlane(tid >> 6);
    const int G = gridDim.x;
    LAS float* scr = (LAS float*)(lds + wave * 8704);
    bf16_t* WT = (bf16_t*)(p.ws + WS_WT); bf16_t* WO = (bf16_t*)(p.ws + WS_WO);
    float* ADAP = (float*)(p.ws + WS_ADAP);
    const int gw = wave * G + blockIdx.x, NGW = G * 8;
    constexpr int N_ADA = 1536, N_TIN = (KDIM / 64) * (DIN / 32), N_TOUT = (KDIM / 64) * (DM / 32);
    for (int it = gw; it < N_ADA + N_TIN + N_TOUT; it += NGW) {
        if (it < N_ADA) {
            const int cgp = it % 96, kc = it / 96, col = cgp * 32 + (lane & 31), kh = (lane >> 5) * 32, k0 = kc * 64;
#pragma unroll
            for (int r = 0; r < 9; ++r) { const float v = (r < 8) ? p.c[r * 1024 + k0 + lane] : p.c_ctx[k0 + lane]; scr[r * 64 + lane] = v * (1.0f / (1.0f + __expf(-v))); }
            asm volatile("s_waitcnt lgkmcnt(0)" ::: "memory");
            float a[9];
#pragma unroll
            for (int r = 0; r < 9; ++r) a[r] = 0.f;
            const float* wp = p.w_ada + (size_t)(k0 + kh) * NADA + col;
#pragma unroll 16
            for (int kk = 0; kk < 32; ++kk) {
                const float w = wp[(size_t)kk * NADA];
#pragma unroll
                for (int r = 0; r < 9; ++r) a[r] += scr[r * 64 + kh + kk] * w;
            }
#pragma unroll
            for (int r = 0; r < 9; ++r) { a[r] += __shfl_xor(a[r], 32); if (lane < 32) ADAP[(size_t)(kc * 9 + r) * NADA + col] = a[r]; }
            asm volatile("s_waitcnt lgkmcnt(0)" ::: "memory");
        } else if (it < N_ADA + N_TIN) {
            p0_transpose_item<true>(p.w_in, DIN, WT, scr, it - N_ADA, lane);
        } else {
            p0_transpose_item<false>(p.w_out, DM, WO, scr, it - N_ADA - N_TIN, lane);
        }
    }
    if (blockIdx.x == 0) {
        float* rope = (float*)(p.ws + WS_ROPE);
        if (tid < 16) {
            double inv = 1.0; for (int i = 0; i < tid; ++i) inv *= 0.5623413251903491;
            const double a = (double)(float)inv;
            double s = 0.0, c = 0.0, term = 1.0;
            for (int n = 0; n < 24; ++n) { if ((n & 1) == 0) c += ((n & 2) ? -term : term); else s += ((n & 2) ? -term : term); term *= a / (double)(n + 1); }
            double cp = 1.0, sp = 0.0;
            for (int pos = 0; pos < 64; ++pos) { rope[pos * 16 + tid] = (float)cp; rope[1024 + pos * 16 + tid] = (float)sp; const double cn = cp * c - sp * s, sn = sp * c + cp * s; cp = cn; sp = sn; }
        }
        if (wave == 1) {
            float mq = fabsf(p.q_norm_g[lane]), mk = fabsf(p.k_norm_g[lane]), mr = 0.f;
            for (int i = lane; i < NH * 15 * 31; i += 64) mr = fmaxf(mr, fabsf(p.rpb[i]));
#pragma unroll
            for (int o = 1; o < 64; o <<= 1) { mq = fmaxf(mq, __shfl_xor(mq, o)); mk = fmaxf(mk, __shfl_xor(mk, o)); mr = fmaxf(mr, __shfl_xor(mr, o)); }
            if (lane == 0) *(float*)(p.ws + WS_BND) = (8.0f * mq * mk + mr) * LOG2E;
        }
    }
}

template <int NR>
__device__ __forceinline__ void p1_rows(const float* src0, bf16_t* dst0, const LAS float* mult, const LAS float* shf, int lane) {
    f32x4 v[NR][4];
#pragma unroll
    for (int r = 0; r < NR; ++r)
#pragma unroll
        for (int j = 0; j < 4; ++j) v[r][j] = __builtin_nontemporal_load((const f32x4*)(src0 + (size_t)r * DM) + lane + 64 * j);
#pragma unroll
    for (int r = 0; r < NR; ++r) {
        float s = 0.f;
#pragma unroll
        for (int j = 0; j < 4; ++j) { const f32x4 t = v[r][j] * v[r][j]; s += (t[0] + t[1]) + (t[2] + t[3]); }
        const float rinv = __builtin_amdgcn_rsqf(wave_sum(s) * (1.0f / DM) + RMS_EPS);
        u32x2* o8 = (u32x2*)(dst0 + (size_t)r * DM) + lane;
#pragma unroll
        for (int j = 0; j < 4; ++j) {
            const f32x4 mu = *(const LAS f32x4*)(mult + 4 * lane + 256 * j), sv = *(const LAS f32x4*)(shf + 4 * lane + 256 * j);
            const f32x4 h = v[r][j] * rinv * mu + sv;
            u32x2 w; w.x = cvtpk(h[0], h[1]); w.y = cvtpk(h[2], h[3]); o8[64 * j] = w;
        }
    }
}
__device__ __forceinline__ void phase1(const Params& p, LAS unsigned char* lds) {
    const int tid = threadIdx.x, lane = tid & 63, wave = __builtin_amdgcn_readfirstlane(tid >> 6);
    LAS float* multL = (LAS float*)lds; LAS float* shfL = (LAS float*)(lds + 4096); LAS float* multC = (LAS float*)(lds + 8192); LAS float* shfC = (LAS float*)(lds + 12288);
    const float* ADAP = (const float*)(p.ws + WS_ADAP);
    bf16_t* XN = (bf16_t*)(p.ws + WS_XN); float* GATE = (float*)(p.ws + WS_GATE);
    for (int slot = blockIdx.x; slot < 256; slot += gridDim.x) {
        const int ci = slot >> 5;
        __syncthreads();
        for (int k = tid; k < 1024; k += NTHREADS) {
            float sh = p.b_ada[k], scl = p.b_ada[1024 + k], shc = sh, sclc = scl;
#pragma unroll
            for (int kc = 0; kc < 16; ++kc) {
                sh += ADAP[(size_t)(kc * 9 + ci) * NADA + k]; scl += ADAP[(size_t)(kc * 9 + ci) * NADA + 1024 + k];
                shc += ADAP[(size_t)(kc * 9 + 8) * NADA + k]; sclc += ADAP[(size_t)(kc * 9 + 8) * NADA + 1024 + k];
            }
            const float g = p.norm_g[k];
            multL[k] = g * (1.0f + scl); shfL[k] = sh; multC[k] = g * (1.0f + sclc); shfC[k] = shc;
            if ((slot & 31) == 0) {
                float gt = p.b_ada[2048 + k];
#pragma unroll
                for (int kc = 0; kc < 16; ++kc) gt += ADAP[(size_t)(kc * 9 + ci) * NADA + 2048 + k];
                GATE[ci * DM + k] = gt;
            }
        }
        __syncthreads();
        const size_t r0 = (size_t)slot * 64 + wave * 8;
        p1_rows<4>(p.x + r0 * DM, XN + r0 * DM, multL, shfL, lane);
        p1_rows<4>(p.x + (r0 + 4) * DM, XN + (r0 + 4) * DM, multL, shfL, lane);
        { const size_t rc = (size_t)slot * 8 + wave; p1_rows<1>(p.ctx + rc * DM, XN + ((size_t)MLAT + rc) * DM, multC, shfC, lane); }
    }
}

__device__ __forceinline__ int swz_k(int key) { return ((key >> 1) & 1) * 2 + ((key >> 3) & 1) * 4; }
__device__ __forceinline__ int swz_v(int d) { return ((d >> 1) & 1) * 2 + ((d >> 2) & 1) * 4; }

__device__ __forceinline__ void glds16(const void* gsrc, unsigned lds_dst) { unsigned keep;
    asm volatile("s_mov_b32 %0, m0\n\ts_mov_b32 m0, %2\n\ts_nop 0\n\tglobal_load_lds_dwordx4 %1, off\n\ts_mov_b32 m0, %0" : "=&s"(keep) : "v"(gsrc), "s"(lds_dst) : "memory"); }

__device__ __forceinline__ void gload16_async(bf16x8& dst, const void* ptr) { asm volatile("global_load_dwordx4 %0, %1, off" : "+v"(dst) : "v"(ptr) : "memory"); }
__device__ __forceinline__ void gload8_async(u32x2& dst, const void* ptr) { asm volatile("global_load_dwordx2 %0, %1, off" : "+v"(dst) : "v"(ptr) : "memory"); }

template <bool LAT>
__device__ __forceinline__ void att_blk(const LAS unsigned char* kc, unsigned ko0, unsigned ko1, const LAS unsigned char* vc, unsigned vo,
                                        const bf16x8 q0, const bf16x8 q1, const LAS float* tb, float B2, unsigned vmask, f32x4 (&o)[4], float& lsum) {
    const bf16x8 k00 = *(const LAS bf16x8*)(kc + ko0), k01 = *(const LAS bf16x8*)(kc + ko1), k10 = *(const LAS bf16x8*)(kc + ko0 + 512), k11 = *(const LAS bf16x8*)(kc + ko1 + 512);
    bf16x8 vf[4];
#pragma unroll
    for (int db = 0; db < 4; ++db) vf[db] = *(const LAS bf16x8*)(vc + vo + db * 2048);
    const f32x4 zero4 = {0.f, 0.f, 0.f, 0.f};
    f32x4 s0 = __builtin_amdgcn_mfma_f32_16x16x32_bf16(k00, q0, zero4, 0, 0, 0); s0 = __builtin_amdgcn_mfma_f32_16x16x32_bf16(k01, q1, s0, 0, 0, 0);
    f32x4 s1 = __builtin_amdgcn_mfma_f32_16x16x32_bf16(k10, q0, zero4, 0, 0, 0); s1 = __builtin_amdgcn_mfma_f32_16x16x32_bf16(k11, q1, s1, 0, 0, 0);
    float pj[8];
#pragma unroll
    for (int j = 0; j < 8; ++j) {
        const float sv = (j < 4 ? s0[j] : s1[j - 4]);
        if (LAT) { const float e = __builtin_amdgcn_exp2f(sv + tb[j]); pj[j] = ((vmask >> j) & 1u) ? e : 0.f; }
        else pj[j] = __builtin_amdgcn_exp2f(sv - B2);
        lsum += pj[j];
    }
    u32x4 pw; pw.x = cvtpk(pj[0], pj[1]); pw.y = cvtpk(pj[2], pj[3]); pw.z = cvtpk(pj[4], pj[5]); pw.w = cvtpk(pj[6], pj[7]);
    const bf16x8 pb = __builtin_bit_cast(bf16x8, pw);
#pragma unroll
    for (int db = 0; db < 4; ++db) o[db] = __builtin_amdgcn_mfma_f32_16x16x32_bf16(vf[db], pb, o[db], 0, 0, 0);
}

struct QcConst { int qcol, dcb; unsigned vmask, ak0, ak1, av; };
__device__ __forceinline__ QcConst make_qc(int qc, int q16, int quad) {
    QcConst c;
    c.qcol = qc * 16 + q16;
    const int cs = (qc == 0) ? 0 : (qc == 1) ? 8 : (qc == 2) ? 24 : 32;
    const int lo = min(max(c.qcol - 8, 0), 48);
    const int kcol0 = cs + 8 * quad;
    c.dcb = kcol0 - c.qcol + 15 + 16;
    c.vmask = 0;
#pragma unroll
    for (int j = 0; j < 8; ++j) { const int kc = kcol0 + j; if (kc >= lo && kc < lo + 16) c.vmask |= (1u << j); }
    const int keyl = cs + 8 * (q16 >> 2) + (q16 & 3);
    c.ak0 = keyl * 128 + ((quad ^ swz_k(keyl)) * 16); c.ak1 = keyl * 128 + (((4 + quad) ^ swz_k(keyl)) * 16);
    c.av = q16 * 128 + ((((cs >> 3) + quad) ^ swz_v(q16)) * 16);
    return c;
}
constexpr int A_CH = 15, A_LAT = 11, A_NS = 6, A_D = 5, A_RING = 32768, A_SLOT = 16384;
__device__ __forceinline__ void phase3(const Params& p, LAS unsigned char* lds) {
    const int tid = threadIdx.x, lane = tid & 63, wave = __builtin_amdgcn_readfirstlane(tid >> 6);
    LAS float* btab = (LAS float*)lds;
    const float B2 = *(const float*)(p.ws + WS_BND);
    {
        float rv[15];
#pragma unroll
        for (int k = 0; k < 15; ++k) { const int idx = tid + k * NTHREADS, c = idx & 63, hd = idx >> 6; const int dc = min(max(c - 16, 0), 30); rv[k] = p.rpb[hd * 31 + dc]; }
#pragma unroll
        for (int k = 0; k < 15; ++k) btab[tid + k * NTHREADS] = rv[k] * LOG2E - B2;
    }
    __syncthreads();
    const int G = gridDim.x, x = blockIdx.x & 7, lb = blockIdx.x >> 3, nb = G >> 3;
    const bf16_t* QP = (const bf16_t*)(p.ws + WS_QP); const bf16_t* QR = (const bf16_t*)(p.ws + WS_QR);
    const bf16_t* KR = (const bf16_t*)(p.ws + WS_KR); const bf16_t* KC = (const bf16_t*)(p.ws + WS_KC);
    const bf16_t* VT = (const bf16_t*)(p.ws + WS_VT); const bf16_t* ZA = (const bf16_t*)(p.ws + WS_ZA);
    bf16_t* MIXo = (bf16_t*)(p.ws + WS_MIX);
    const unsigned lds0 = (unsigned)(size_t)lds;
    const int n_items = lb < 64 ? (64 - lb + nb - 1) / nb : 0;
    const int total = n_items * A_CH;
    const int irow = wave >> 1, qcp = wave & 1;
    const int q16 = lane & 15, quad = lane >> 4;
    const QcConst cA = make_qc(2 * qcp, q16, quad), cB = make_qc(2 * qcp + 1, q16, quad);
    const int keyc = 8 * (q16 >> 2) + (q16 & 3);
    const unsigned ck0 = keyc * 128 + ((quad ^ swz_k(keyc)) * 16), ck1 = keyc * 128 + (((4 + quad) ^ swz_k(keyc)) * 16);
    const unsigned cv0 = q16 * 128 + ((quad ^ swz_v(q16)) * 16), cv1 = q16 * 128 + (((4 + quad) ^ swz_v(q16)) * 16);
    const int drow = wave * 8 + (lane >> 3), dsl = lane & 7;
    const size_t ksrc_off = (size_t)drow * HD + ((dsl ^ swz_k(drow)) * 8);
    const size_t vsrc_off = (size_t)drow * MTOT + ((dsl ^ swz_v(drow)) * 8);
#define A_ISSUE(seq_) do { const int _n = (seq_) / A_CH, _cj = (seq_) - _n * A_CH, _li = lb + _n * nb, _bh = 8 * x + (_li >> 3), _i0 = 4 * (_li & 7); \
        const int _b = _bh >> 3, _h = _bh & 7, _R0 = min(max(_i0 - 4, 0), 24); const int _slot = (seq_) % A_NS; \
        const bf16_t* _ks; const bf16_t* _vs; \
        if (_cj < A_LAT) { const int _r = min(_R0 + _cj, 31); _ks = KR + ((size_t)_bh * SEQ + _r * 64) * HD + ksrc_off; _vs = VT + (size_t)(_h * HD) * MTOT + _b * SEQ + _r * 64 + vsrc_off; } \
        else { const int _c = _cj - A_LAT; _ks = KC + ((size_t)_bh * CTXL + _c * 64) * HD + ksrc_off; _vs = VT + (size_t)(_h * HD) * MTOT + MLAT + _b * CTXL + _c * 64 + vsrc_off; } \
        glds16(_ks, (unsigned)__builtin_amdgcn_readfirstlane((int)(lds0 + A_RING + _slot * A_SLOT + wave * 1024))); \
        glds16(_vs, (unsigned)__builtin_amdgcn_readfirstlane((int)(lds0 + A_RING + _slot * A_SLOT + 8192 + wave * 1024))); } while (0)
#define A_LOADQ(n_) do { const int _li = lb + (n_) * nb, _bh = 8 * x + (_li >> 3), _i = 4 * (_li & 7) + irow; \
        const size_t _qa = ((size_t)_bh * SEQ + _i * 64 + cA.qcol) * HD + quad * 8, _qb = ((size_t)_bh * SEQ + _i * 64 + cB.qcol) * HD + quad * 8; \
        qrA0 = *(const bf16x8*)(QR + _qa); qrA1 = *(const bf16x8*)(QR + _qa + 32); qpA0 = *(const bf16x8*)(QP + _qa); qpA1 = *(const bf16x8*)(QP + _qa + 32); \
        qrB0 = *(const bf16x8*)(QR + _qb); qrB1 = *(const bf16x8*)(QR + _qb + 32); qpB0 = *(const bf16x8*)(QP + _qb); qpB1 = *(const bf16x8*)(QP + _qb + 32); } while (0)
    bf16x8 qrA0, qrA1, qpA0, qpA1, qrB0, qrB1, qpB0, qpB1;
    if (n_items > 0) A_LOADQ(0);
    for (int s = 0; s < A_D && s < total; ++s) A_ISSUE(s);
    f32x4 oA[4], oB[4]; float lsA = 0.f, lsB = 0.f; u32x2 zA[4], zB[4];
#pragma unroll
    for (int db = 0; db < 4; ++db) { oA[db] = (f32x4){0.f, 0.f, 0.f, 0.f}; oB[db] = (f32x4){0.f, 0.f, 0.f, 0.f}; zA[db] = (u32x2){0u, 0u}; zB[db] = (u32x2){0u, 0u}; }
    int n = 0, cj = 0;
    for (int seq = 0; seq < total; ++seq) {
        const int rem = total - 1 - seq;
        if (rem >= 4) asm volatile("s_waitcnt vmcnt(8)" ::: "memory");
        else if (rem == 3) asm volatile("s_waitcnt vmcnt(6)" ::: "memory");
        else if (rem == 2) asm volatile("s_waitcnt vmcnt(4)" ::: "memory");
        else if (rem == 1) asm volatile("s_waitcnt vmcnt(2)" ::: "memory");
        else asm volatile("s_waitcnt vmcnt(0)" ::: "memory");
        __builtin_amdgcn_s_barrier();
        asm volatile("" ::: "memory");
        if (seq + A_D < total) A_ISSUE(seq + A_D);
        const int li = lb + n * nb, bh = 8 * x + (li >> 3), i0 = 4 * (li & 7), i = i0 + irow, b = bh >> 3, h = bh & 7;
        const LAS unsigned char* kc = lds + A_RING + (seq % A_NS) * A_SLOT; const LAS unsigned char* vc = kc + 8192;
        if (cj < A_LAT) {
            const int R0 = min(max(i0 - 4, 0), 24), rowu = R0 + cj, rsw = min(max(i - 4, 0), 24);
            if (rowu >= rsw && rowu < rsw + 8) {
                const int dr = rowu - i + 7;
                const LAS float* tb = btab + (h * 15 + dr) * 64;
                att_blk<true>(kc, cA.ak0, cA.ak1, vc, cA.av, qrA0, qrA1, tb + cA.dcb, B2, cA.vmask, oA, lsA);
                att_blk<true>(kc, cB.ak0, cB.ak1, vc, cB.av, qrB0, qrB1, tb + cB.dcb, B2, cB.vmask, oB, lsB);
            }
        } else {
            if (cj == A_LAT) {
                const size_t tokz = (size_t)b * SEQ + i * 64;
#pragma unroll
                for (int db = 0; db < 4; ++db) { zA[db] = *(const u32x2*)(ZA + (tokz + cA.qcol) * 512 + h * HD + 16 * db + 4 * quad); zB[db] = *(const u32x2*)(ZA + (tokz + cB.qcol) * 512 + h * HD + 16 * db + 4 * quad); }
            }
            att_blk<false>(kc, ck0, ck1, vc, cv0, qpA0, qpA1, nullptr, B2, 0u, oA, lsA);
            att_blk<false>(kc, ck0, ck1, vc, cv0, qpB0, qpB1, nullptr, B2, 0u, oB, lsB);
            att_blk<false>(kc + 4096, ck0, ck1, vc, cv1, qpA0, qpA1, nullptr, B2, 0u, oA, lsA);
            att_blk<false>(kc + 4096, ck0, ck1, vc, cv1, qpB0, qpB1, nullptr, B2, 0u, oB, lsB);
        }
        if (++cj == A_CH) {
            lsA += __shfl_xor(lsA, 16); lsA += __shfl_xor(lsA, 32); lsB += __shfl_xor(lsB, 16); lsB += __shfl_xor(lsB, 32);
            const float invA = 1.0f / lsA, invB = 1.0f / lsB;
            const size_t tok = (size_t)b * SEQ + i * 64;
#pragma unroll
            for (int db = 0; db < 4; ++db) {
                { const float z0 = __builtin_bit_cast(float, zA[db].x << 16), z1 = __builtin_bit_cast(float, zA[db].x & 0xffff0000u), z2 = __builtin_bit_cast(float, zA[db].y << 16), z3 = __builtin_bit_cast(float, zA[db].y & 0xffff0000u);
                  u32x2 w; w.x = cvtpk(oA[db][0] * invA * z0, oA[db][1] * invA * z1); w.y = cvtpk(oA[db][2] * invA * z2, oA[db][3] * invA * z3);
                  *(u32x2*)(MIXo + (tok + cA.qcol) * DM + h * HD + 16 * db + 4 * quad) = w; oA[db] = (f32x4){0.f, 0.f, 0.f, 0.f}; }
                { const float z0 = __builtin_bit_cast(float, zB[db].x << 16), z1 = __builtin_bit_cast(float, zB[db].x & 0xffff0000u), z2 = __builtin_bit_cast(float, zB[db].y << 16), z3 = __builtin_bit_cast(float, zB[db].y & 0xffff0000u);
                  u32x2 w; w.x = cvtpk(oB[db][0] * invB * z0, oB[db][1] * invB * z1); w.y = cvtpk(oB[db][2] * invB * z2, oB[db][3] * invB * z3);
                  *(u32x2*)(MIXo + (tok + cB.qcol) * DM + h * HD + 16 * db + 4 * quad) = w; oB[db] = (f32x4){0.f, 0.f, 0.f, 0.f}; }
            }
            lsA = 0.f; lsB = 0.f; cj = 0; ++n;
            if (n < n_items) A_LOADQ(n);
        }
    }
#undef A_ISSUE
#undef A_LOADQ
    __syncthreads();
}
__device__ __forceinline__ void phase3_conv(const Params& p) {
    const int tid = threadIdx.x, G = gridDim.x;
    const bf16_t* CG = (const bf16_t*)(p.ws + WS_CG); bf16_t* MIX = (bf16_t*)(p.ws + WS_MIX);
    const int g = tid & 127, sub = tid >> 7;
    const f32x4 w0 = *(const f32x4*)(p.conv_w + 4 * g), w1 = *(const f32x4*)(p.conv_w + 512 + 4 * g), w2 = *(const f32x4*)(p.conv_w + 1024 + 4 * g), cb = *(const f32x4*)(p.conv_b + 4 * g);
#define LO16(u) __builtin_bit_cast(float, (u) << 16)
#define HI16(u) __builtin_bit_cast(float, (u) & 0xffff0000u)
    for (int chunk = blockIdx.x; chunk < MLAT / 32; chunk += G) {
        const int tok0 = chunk * 32 + sub * 8, t0 = tok0 & (SEQ - 1);
        const bf16_t* src = CG + (size_t)tok0 * 1024 + g * 8;
        u32x4 cur[8]; u32x2 pv = {0u, 0u}, nv = {0u, 0u};
#pragma unroll
        for (int k = 0; k < 8; ++k) cur[k] = *(const u32x4*)(src + (size_t)k * 1024);
        if (t0 > 0) pv = *(const u32x2*)(src - 1024);
        if (t0 + 8 < SEQ) nv = *(const u32x2*)(src + 8 * 1024);
        f32x4 cprev = {LO16(pv.x), HI16(pv.x), LO16(pv.y), HI16(pv.y)};
        f32x4 cc = {LO16(cur[0].x), HI16(cur[0].x), LO16(cur[0].y), HI16(cur[0].y)};
#pragma unroll
        for (int k = 0; k < 8; ++k) {
            const u32x2 nx = (k < 7) ? (u32x2){cur[k < 7 ? k + 1 : 7].x, cur[k < 7 ? k + 1 : 7].y} : nv;
            const f32x4 cn = {LO16(nx.x), HI16(nx.x), LO16(nx.y), HI16(nx.y)};
            const f32x4 gz = {LO16(cur[k].z), HI16(cur[k].z), LO16(cur[k].w), HI16(cur[k].w)};
            const f32x4 y = gz * (cb + w0 * cprev + w1 * cc + w2 * cn);
            u32x2 w; w.x = cvtpk(y[0], y[1]); w.y = cvtpk(y[2], y[3]);
            *(u32x2*)(MIX + (size_t)(tok0 + k) * DM + 512 + 4 * g) = w;
            cprev = cc; cc = cn;
        }
    }
#undef LO16
#undef HI16
}

#define XB_TMO      128
#define XB_XCNT(j)  (256  + 64 * (j))
#define XB_XSUB(j)  (1280 + 64 * (j))
#define XB_XGEN(j)  (2304 + 64 * (j))
#define XB_TOP      3328
#define XB_TOPGEN   3392
#define XCD_BAR_WORDS 3456
#define XB_SPIN_CAP (1u << 18)
__device__ __forceinline__ unsigned xb_ld(unsigned* p)              { return __hip_atomic_load(p, __ATOMIC_RELAXED, __HIP_MEMORY_SCOPE_AGENT); }
__device__ __forceinline__ unsigned xb_add(unsigned* p, unsigned v) { return __hip_atomic_fetch_add(p, v, __ATOMIC_RELAXED, __HIP_MEMORY_SCOPE_AGENT); }
__device__ __forceinline__ unsigned xb_xcc_id() { return (unsigned)__builtin_amdgcn_s_getreg((3 << 11) | 20) & 0xFu; }
#define XB_SPIN(cond, bar) do { unsigned _sp = 0; while (cond) { __builtin_amdgcn_s_sleep(1); \
    if ((++_sp & 255u) == 0u) { if (xb_ld(&(bar)[XB_TMO])) break; if (_sp > XB_SPIN_CAP) { atomicAdd(&(bar)[XB_TMO], 1u); break; } } } } while (0)
struct XcdBarrier { unsigned* bar; unsigned x; volatile LAS unsigned* st; };
__device__ __forceinline__ XcdBarrier xcd_barrier_post(unsigned* bar, volatile LAS unsigned* st) {
    XcdBarrier b; b.bar = bar; b.x = xb_xcc_id(); b.st = st;
    if (threadIdx.x == 0) (void)xb_add(&bar[XB_XCNT(b.x)], 1u);
    return b;
}
__device__ __forceinline__ void xcd_barrier_complete(unsigned* bar, unsigned x, unsigned& nloc, unsigned& nx) {
    const unsigned G = gridDim.x * gridDim.y * gridDim.z;
    unsigned sum, cnt, mine, sp = 0u;
    for (;;) {
        sum = 0u; cnt = 0u; mine = 0u;
#pragma unroll
        for (unsigned j = 0; j < 16; ++j) { const unsigned c = xb_ld(&bar[XB_XCNT(j)]); sum += c; cnt += (c > 0u) ? 1u : 0u; mine = (j == x) ? c : mine; }
        if (sum == G) break;
        __builtin_amdgcn_s_sleep(1);
        if ((++sp & 255u) == 0u) { if (xb_ld(&bar[XB_TMO])) break; if (sp > XB_SPIN_CAP) { atomicAdd(&bar[XB_TMO], 1u); break; } }
    }
    nloc = mine > 0u ? mine : 1u; nx = cnt > 0u ? cnt : 1u;
}
__device__ __forceinline__ void xcd_barrier(const XcdBarrier& b) {
    asm volatile("s_waitcnt vmcnt(0)" ::: "memory");
    __syncthreads();
    if (threadIdx.x == 0) {
        unsigned* bar = b.bar;
        __builtin_amdgcn_s_waitcnt(0);
        unsigned nloc = b.st[0], nx = b.st[1];
        if (nloc == 0u) { xcd_barrier_complete(bar, b.x, nloc, nx); b.st[0] = nloc; b.st[1] = nx; }
        const unsigned old = xb_add(&bar[XB_XSUB(b.x)], 1u);
        const unsigned gen = old / nloc;
        if (old + 1u == (gen + 1u) * nloc) {
            __builtin_amdgcn_fence(__ATOMIC_RELEASE, "agent");
            asm volatile("s_waitcnt vmcnt(0)" ::: "memory");
            const unsigned og = xb_add(&bar[XB_TOP], 1u);
            const unsigned tg = og / nx;
            if (og + 1u == (tg + 1u) * nx) xb_add(&bar[XB_TOPGEN], 1u);
            else XB_SPIN(xb_ld(&bar[XB_TOPGEN]) == tg, bar);
            __builtin_amdgcn_fence(__ATOMIC_ACQUIRE, "agent");
            xb_add(&bar[XB_XGEN(b.x)], 1u);
            asm volatile("s_waitcnt vmcnt(0)" ::: "memory");
        } else {
            XB_SPIN(xb_ld(&bar[XB_XGEN(b.x)]) == gen, bar);
            __builtin_amdgcn_fence(__ATOMIC_ACQUIRE, "agent");
            asm volatile("s_waitcnt vmcnt(0)" ::: "memory");
        }
    }
    __syncthreads();
}

__global__ void __launch_bounds__(NTHREADS, 2) fwd_megakernel(Params p) {
    extern __shared__ __attribute__((aligned(16))) unsigned char lds_raw[];
    LAS unsigned char* lds = (LAS unsigned char*)lds_raw;
    cg::grid_group grid = cg::this_grid();
    if (threadIdx.x < 16) ((LAS unsigned*)(lds + LDS_MISC))[threadIdx.x] = 0u;
    __syncthreads();
    XcdBarrier xbar = xcd_barrier_post((unsigned*)(p.ws + WS_BAR), (volatile LAS unsigned*)(lds + LDS_MISC));
    if (p.ph_lo < 0) grid.sync();
#define GSYNC() xcd_barrier(xbar)
    const int lo = p.ph_lo, hi = p.ph_hi;
    const int x = blockIdx.x & 7, lb = blockIdx.x >> 3, nb = gridDim.x >> 3;
    EpiCtx E;
    E.QP = (bf16_t*)(p.ws + WS_QP); E.QR = (bf16_t*)(p.ws + WS_QR); E.KR = (bf16_t*)(p.ws + WS_KR); E.KC = (bf16_t*)(p.ws + WS_KC);
    E.VT = (bf16_t*)(p.ws + WS_VT); E.ZA = (bf16_t*)(p.ws + WS_ZA); E.CG = (bf16_t*)(p.ws + WS_CG);
    E.gq = p.q_norm_g; E.gk = p.k_norm_g; E.rope = (const float*)(p.ws + WS_ROPE);
    E.x = p.x; E.gate = (const float*)(p.ws + WS_GATE); E.out = p.out;
#define IN(k) (lo <= (k) && (k) < hi)
#define SEAM(k) do { if (IN(k) && IN((k) + 1)) GSYNC(); } while (0)
#define REP(k, ...) do { if (IN(k)) { __VA_ARGS__; if (PROBE_REP == (k)) { GSYNC(); __VA_ARGS__; } } } while (0)
    REP(0, phase0(p, lds));
    SEAM(0);
    REP(1, phase1(p, lds));
    SEAM(1);
    REP(2, { SchedP2 S{x, lb, nb, (const char*)(p.ws + WS_XN), (const char*)(p.ws + WS_WT)}; gemm_phase<2>(lds, S, E); });
    SEAM(2);
    REP(3, phase3(p, lds));
    if (IN(3)) { phase3_conv(p); if (PROBE_REP == 31) { GSYNC(); phase3_conv(p); } }
    SEAM(3);
    REP(4, { SchedP4 S{x, lb, nb, (const char*)(p.ws + WS_MIX), (const char*)(p.ws + WS_WO)}; gemm_phase<4>(lds, S, E); });
#undef REP
    if (PROBE_REP == 99) { GSYNC(); GSYNC(); GSYNC(); GSYNC(); }
#undef IN
#undef SEAM
}

extern "C" void kernel_launch(void* const* d_in, const int* in_sizes, int n_in, void* d_out, int out_size, void* d_ws, size_t ws_size, hipStream_t stream) {
    static int grid = 0;
    if (grid == 0) {
        int dev = 0, cus = 0, per_cu = 0;
        hipGetDevice(&dev);
        hipDeviceGetAttribute(&cus, hipDeviceAttributeMultiprocessorCount, dev);
        if (hipFuncSetAttribute((const void*)fwd_megakernel, hipFuncAttributeMaxDynamicSharedMemorySize, LDS_BYTES) != hipSuccess) { fprintf(stderr, "hipFuncSetAttribute failed\n"); grid = -1; return; }
        hipOccupancyMaxActiveBlocksPerMultiprocessor(&per_cu, (const void*)fwd_megakernel, NTHREADS, LDS_BYTES);
        if (per_cu < 1) { fprintf(stderr, "occupancy query says %d blocks per CU\n", per_cu); grid = -1; return; }
        grid = cus;
        grid -= grid % 8;
        if (n_in != 14 || ws_size < WS_END || grid < 8) { fprintf(stderr, "unexpected problem geometry\n"); grid = -1; return; }
    }
    if (grid < 0) return;
    Params p{};
    p.x = (const float*)d_in[0]; p.c = (const float*)d_in[1]; p.ctx = (const float*)d_in[2]; p.c_ctx = (const float*)d_in[3];
    p.w_ada = (const float*)d_in[4]; p.b_ada = (const float*)d_in[5]; p.norm_g = (const float*)d_in[6]; p.w_in = (const float*)d_in[7];
    p.q_norm_g = (const float*)d_in[8]; p.k_norm_g = (const float*)d_in[9]; p.rpb = (const float*)d_in[10]; p.conv_w = (const float*)d_in[11];
    p.conv_b = (const float*)d_in[12]; p.w_out = (const float*)d_in[13];
    p.out = (float*)d_out; p.ws = (unsigned char*)d_ws;
    if (hipMemsetAsync((char*)d_ws + WS_BAR, 0, BAR_BYTES, stream) != hipSuccess) { fprintf(stderr, "memset of barrier words failed\n"); return; }
#if N_LAUNCH_MODE == 1
    p.ph_lo = 0; p.ph_hi = 5;
    void* args[] = {&p};
    hipError_t e = hipLaunchCooperativeKernel((const void*)fwd_megakernel, dim3(grid), dim3(NTHREADS), args, LDS_BYTES, stream);
    if (e != hipSuccess) fprintf(stderr, "cooperative launch failed: %s (grid %d)\n", hipGetErrorString(e), grid);
#else
    for (int ph = 0; ph < 5; ++ph) {
        p.ph_lo = ph; p.ph_hi = ph + 1;
        hipLaunchKernelGGL(fwd_megakernel, dim3(grid), dim3(NTHREADS), LDS_BYTES, stream, p);
    }
#endif
}
```

```cpp
#include <hip/hip_runtime.h>
#include <hip/hip_cooperative_groups.h>
#include <cstdio>
#include <cstdint>
namespace cg = cooperative_groups;

#ifndef N_LAUNCH_MODE
#define N_LAUNCH_MODE 1
#endif

#ifndef PROBE_REP
#define PROBE_REP -1
#endif

#define LAS __attribute__((address_space(3)))
typedef unsigned short bf16_t;
typedef short bf16x8 __attribute__((ext_vector_type(8)));
typedef float f32x4 __attribute__((ext_vector_type(4)));
typedef float f32x2 __attribute__((ext_vector_type(2)));
typedef unsigned u32x4 __attribute__((ext_vector_type(4)));
typedef unsigned u32x2 __attribute__((ext_vector_type(2)));
typedef __bf16 bf16x2_t __attribute__((ext_vector_type(2)));

constexpr int NBATCH = 8, SEQ = 2048, DM = 1024, CTXL = 256, NH = 8, HD = 64;
constexpr int MLAT = NBATCH * SEQ, MCTX = NBATCH * CTXL, MTOT = MLAT + MCTX;
constexpr int DIN = 4096, NADA = 3072;
constexpr float RMS_EPS = 1e-6f;
constexpr float LOG2E = 1.4426950408889634f;

constexpr size_t MiB = 1u << 20;
constexpr size_t WS_WT = 0;
constexpr size_t WS_WO = 8 * MiB;
constexpr size_t WS_ADAP = 196 * MiB;
constexpr size_t WS_GATE = 11 * MiB;
constexpr size_t WS_ROPE = 11 * MiB + 65536;
constexpr size_t WS_BND = 11 * MiB + 131072;
constexpr size_t WS_BAR = 11 * MiB + 262144;
constexpr size_t BAR_BYTES = 16384;
constexpr int LDS_MISC = 147456 - 64;
constexpr size_t WS_XN = 12 * MiB;
constexpr size_t WS_QP = 48 * MiB;
constexpr size_t WS_QR = 64 * MiB;
constexpr size_t WS_KR = 80 * MiB;
constexpr size_t WS_KC = 96 * MiB;
constexpr size_t WS_VT = 98 * MiB;
constexpr size_t WS_ZA = 116 * MiB;
constexpr size_t WS_CG = 132 * MiB;
constexpr size_t WS_MIX = 164 * MiB;
constexpr size_t WS_END = 198 * MiB;

constexpr int LDS_BYTES = 147456;
constexpr int NTHREADS = 512;

struct Params {
    const float *x, *c, *ctx, *c_ctx, *w_ada, *b_ada, *norm_g, *w_in, *q_norm_g, *k_norm_g, *rpb, *conv_w, *conv_b, *w_out;
    float* out; unsigned char* ws; int ph_lo, ph_hi;
};

__device__ __forceinline__ unsigned cvtpk(float lo, float hi) { f32x2 v = {lo, hi}; bf16x2_t b = __builtin_convertvector(v, bf16x2_t); return __builtin_bit_cast(unsigned, b); }
__device__ __forceinline__ float bf2f(unsigned short h) { return __builtin_bit_cast(float, (unsigned)h << 16); }
__device__ __forceinline__ float silu_f(float v) { return v * __builtin_amdgcn_rcpf(1.0f + __builtin_amdgcn_exp2f(-v * LOG2E)); }
__device__ __forceinline__ float wave_sum(float v) {
#pragma unroll
    for (int o = 1; o < 64; o <<= 1) v += __shfl_xor(v, o);
    return v;
}

constexpr int BM = 256, BK = 64, HALF = 128, HTB = HALF * BK * 2, KDIM = 1024;
constexpr size_t TSTEP = (size_t)BM * KDIM * 2;
__device__ __forceinline__ int lds_byte(int r, int c) { const int st = (r >> 4) * 2 + (c >> 5), rr = r & 15, cc = c & 31, ob = rr * 64 + cc * 2; return st * 1024 + (ob ^ (((ob >> 9) & 1) << 5)); }
__device__ __forceinline__ void stage_rc(int b, int& R, int& C) { const int st = b / 1024, sb = b % 1024, swz = sb ^ (((sb >> 9) & 1) << 5); R = (st >> 1) * 16 + swz / 64; C = (st & 1) * 32 + (swz % 64) / 2; }
__device__ __forceinline__ int perm32(int rho) { const int n = rho >> 4, i = rho & 15; return 8 * (i >> 2) + 4 * n + (i & 3); }

struct Unit { const char* a; const char* b; int kind, pm, pn; };

struct EpiCtx {
    bf16_t *QP, *QR, *KR, *KC, *VT, *ZA, *CG;
    const float *gq, *gk, *rope;
    const float *x, *gate; float* out;
};

template <int PH>
__device__ __forceinline__ void epilogue(const f32x4 (&acc)[2][2][4][2], const Unit& u, int wr, int wc, int fr, int fq, const EpiCtx& E) {
    if constexpr (PH == 4) {
        const int b = (u.pm * BM) >> 11;
        const int c0 = u.pn * BM + wc * 32 + fq * 8;
        f32x4 gv[2][2];
#pragma unroll
        for (int bj = 0; bj < 2; ++bj)
#pragma unroll
            for (int n = 0; n < 2; ++n) gv[bj][n] = *(const f32x4*)(E.gate + b * DM + c0 + bj * HALF + 4 * n);
        const float* __restrict__ xp = E.x; float* __restrict__ op = E.out;
#pragma unroll
        for (int ai = 0; ai < 2; ++ai)
#pragma unroll
            for (int mp = 0; mp < 2; ++mp) {
                f32x4 xv[2][2][2];
#pragma unroll
                for (int mm = 0; mm < 2; ++mm) {
                    const size_t off = (size_t)(u.pm * BM + ai * HALF + wr * 64 + (2 * mp + mm) * 16 + fr) * DM + c0;
#pragma unroll
                    for (int bj = 0; bj < 2; ++bj)
#pragma unroll
                        for (int n = 0; n < 2; ++n) xv[mm][bj][n] = __builtin_nontemporal_load((const f32x4*)(xp + off + bj * HALF + 4 * n));
                }
#pragma unroll
                for (int mm = 0; mm < 2; ++mm) {
                    const size_t off = (size_t)(u.pm * BM + ai * HALF + wr * 64 + (2 * mp + mm) * 16 + fr) * DM + c0;
#pragma unroll
                    for (int bj = 0; bj < 2; ++bj)
#pragma unroll
                        for (int n = 0; n < 2; ++n) __builtin_nontemporal_store(xv[mm][bj][n] + gv[bj][n] * acc[ai][bj][2 * mp + mm][n], (f32x4*)(op + off + bj * HALF + 4 * n));
                }
            }
    } else {
        const int kind = u.kind;
        if (kind == 0 || kind == 1 || kind == 5) {
            const bool isq = (kind == 0);
            const float* g = isq ? E.gq : E.gk;
            const float qs = isq ? 0.125f * LOG2E : 1.0f;
            const int head = 4 * (u.pn & 1) + wc;
            f32x4 gv[2][2];
#pragma unroll
            for (int bj = 0; bj < 2; ++bj)
#pragma unroll
                for (int n = 0; n < 2; ++n) gv[bj][n] = *(const f32x4*)(g + 32 * bj + 16 * n + 4 * fq);
#pragma unroll
            for (int ai = 0; ai < 2; ++ai)
#pragma unroll
                for (int m = 0; m < 4; ++m) {
                    const int r = u.pm * BM + ai * HALF + wr * 64 + m * 16 + fr;
                    f32x4 v[2][2]; float ss = 0.f;
#pragma unroll
                    for (int bj = 0; bj < 2; ++bj)
#pragma unroll
                        for (int n = 0; n < 2; ++n) { v[bj][n] = acc[ai][bj][m][n]; const f32x4 t = v[bj][n] * v[bj][n]; ss += (t[0] + t[1]) + (t[2] + t[3]); }
                    ss += __shfl_xor(ss, 16); ss += __shfl_xor(ss, 32);
                    const float rinv = __builtin_amdgcn_rsqf(ss * (1.0f / 64.0f) + RMS_EPS) * qs;
#pragma unroll
                    for (int bj = 0; bj < 2; ++bj)
#pragma unroll
                        for (int n = 0; n < 2; ++n) v[bj][n] = v[bj][n] * rinv * gv[bj][n];
                    if (kind == 5) {
                        const int rc = r - MLAT, b = rc >> 8, l = rc & 255;
                        bf16_t* dst = E.KC + ((size_t)((b * NH + head) * CTXL + l)) * HD + fq * 16;
#pragma unroll
                        for (int bj = 0; bj < 2; ++bj) { u32x4 w; w.x = cvtpk(v[bj][0][0], v[bj][0][1]); w.y = cvtpk(v[bj][0][2], v[bj][0][3]); w.z = cvtpk(v[bj][1][0], v[bj][1][1]); w.w = cvtpk(v[bj][1][2], v[bj][1][3]); *(u32x4*)(dst + bj * 8) = w; }
                    } else {
                        const int b = r >> 11, t = r & 2047, grow = t >> 6, gcol = t & 63;
                        const size_t rowoff = ((size_t)((b * NH + head) * SEQ + t)) * HD + fq * 16;
                        if (isq) {
                            bf16_t* dst = E.QP + rowoff;
#pragma unroll
                            for (int bj = 0; bj < 2; ++bj) { u32x4 w; w.x = cvtpk(v[bj][0][0], v[bj][0][1]); w.y = cvtpk(v[bj][0][2], v[bj][0][3]); w.z = cvtpk(v[bj][1][0], v[bj][1][1]); w.w = cvtpk(v[bj][1][2], v[bj][1][3]); *(u32x4*)(dst + bj * 8) = w; }
                        }
                        bf16_t* dst = (isq ? E.QR : E.KR) + rowoff;
#pragma unroll
                        for (int bj = 0; bj < 2; ++bj) {
                            const int pos = bj ? gcol : grow;
                            const f32x4 cs = *(const f32x4*)(E.rope + pos * 16 + 4 * fq), sn = *(const f32x4*)(E.rope + 1024 + pos * 16 + 4 * fq);
                            const f32x4 o0 = v[bj][0] * cs - v[bj][1] * sn, o1 = v[bj][1] * cs + v[bj][0] * sn;
                            u32x4 w; w.x = cvtpk(o0[0], o0[1]); w.y = cvtpk(o0[2], o0[3]); w.z = cvtpk(o1[0], o1[1]); w.w = cvtpk(o1[2], o1[3]);
                            *(u32x4*)(dst + bj * 8) = w;
                        }
                    }
                }
        } else if (kind == 2) {
            const int c0 = (u.pn - 6) * BM + wc * 32 + fq * 8;
#pragma unroll
            for (int ai = 0; ai < 2; ++ai)
#pragma unroll
                for (int m = 0; m < 4; ++m) {
                    bf16_t* dst = E.ZA + (size_t)(u.pm * BM + ai * HALF + wr * 64 + m * 16 + fr) * 512 + c0;
#pragma unroll
                    for (int bj = 0; bj < 2; ++bj) {
                        const f32x4 a0 = acc[ai][bj][m][0], a1 = acc[ai][bj][m][1];
                        u32x4 w; w.x = cvtpk(silu_f(a0[0]), silu_f(a0[1])); w.y = cvtpk(silu_f(a0[2]), silu_f(a0[3])); w.z = cvtpk(silu_f(a1[0]), silu_f(a1[1])); w.w = cvtpk(silu_f(a1[2]), silu_f(a1[3]));
                        *(u32x4*)(dst + bj * HALF) = w;
                    }
                }
        } else if (kind == 3) {
            const int ch0 = (u.pn - 8) * 64 + wc * 16 + fq * 4;
#pragma unroll
            for (int ai = 0; ai < 2; ++ai)
#pragma unroll
                for (int m = 0; m < 4; ++m) {
                    const f32x4 uu = acc[ai][0][m][0], bg = acc[ai][0][m][1], cgv = acc[ai][1][m][0], zc = acc[ai][1][m][1];
                    const f32x4 cu = cgv * uu;
                    f32x4 gz;
#pragma unroll
                    for (int j = 0; j < 4; ++j) gz[j] = bg[j] * silu_f(zc[j]);
                    u32x4 w; w.x = cvtpk(cu[0], cu[1]); w.y = cvtpk(cu[2], cu[3]); w.z = cvtpk(gz[0], gz[1]); w.w = cvtpk(gz[2], gz[3]);
                    *(u32x4*)(E.CG + (size_t)(u.pm * BM + ai * HALF + wr * 64 + m * 16 + fr) * 1024 + ch0 * 2) = w;
                }
        } else {
            const int c0 = u.pn * BM + wc * 32 + fq * 8;
#pragma unroll
            for (int ai = 0; ai < 2; ++ai)
#pragma unroll
                for (int m = 0; m < 4; ++m) {
                    bf16_t* dst = E.VT + (size_t)(u.pm * BM + ai * HALF + wr * 64 + m * 16 + fr) * MTOT + c0;
#pragma unroll
                    for (int bj = 0; bj < 2; ++bj) {
                        const f32x4 a0 = acc[ai][bj][m][0], a1 = acc[ai][bj][m][1];
                        u32x4 w; w.x = cvtpk(a0[0], a0[1]); w.y = cvtpk(a0[2], a0[3]); w.z = cvtpk(a1[0], a1[1]); w.w = cvtpk(a1[2], a1[3]);
                        *(u32x4*)(dst + bj * HALF) = w;
                    }
                }
        }
    }
}

struct SchedP2 {
    int x, lb, nb; const char* XN; const char* WT;
    __device__ __forceinline__ bool next(int i, Unit& u) const {
        const int uu = lb + i * nb; if (uu >= 132) return false;
        if (uu < 112) {
            const int pi = uu >> 3, pm = 8 * x + (uu & 7), pn = pi < 4 ? pi : pi + 2;
            u.kind = pn < 2 ? 0 : (pn < 4 ? 1 : (pn < 8 ? 2 : 3)); u.pm = pm; u.pn = pn; u.a = XN + (size_t)pm * TSTEP; u.b = WT + (size_t)pn * TSTEP;
        } else if (uu < 130) {
            const int v = uu - 112, pnp = 9 * x + v % 9, pmp = v / 9;
            u.kind = 4; u.pm = pmp; u.pn = pnp; u.a = WT + (size_t)(4 + pmp) * TSTEP; u.b = XN + (size_t)pnp * TSTEP;
        } else {
            u.kind = 5; u.pm = 64 + x; u.pn = 2 + (uu - 130); u.a = XN + (size_t)u.pm * TSTEP; u.b = WT + (size_t)u.pn * TSTEP;
        }
        return true;
    }
};
struct SchedP4 {
    int x, lb, nb; const char* MIX; const char* WO;
    __device__ __forceinline__ bool next(int i, Unit& u) const {
        const int uu = lb + i * nb; if (uu >= 32) return false;
        u.kind = 6; u.pm = 8 * x + (uu & 7); u.pn = uu >> 3; u.a = MIX + (size_t)u.pm * TSTEP; u.b = WO + (size_t)u.pn * TSTEP; return true;
    }
};

template <int PH, class Sched>
__device__ __forceinline__ void gemm_phase(LAS unsigned char* lds, const Sched& S, const EpiCtx& E) {
    const int tid = threadIdx.x, wid = __builtin_amdgcn_readfirstlane(tid >> 6), lane = tid & 63, wr = wid >> 2, wc = wid & 3, fr = lane & 15, fq = lane >> 4;
    constexpr int K = KDIM, nt = K / BK;
    unsigned voffA[2], voffB[2];
#pragma unroll
    for (int i = 0; i < 2; ++i) { int R, C; stage_rc(tid * 16 + i * 8192, R, C); const int Rb = (R & ~31) + perm32(R & 31);
        voffA[i] = (unsigned)(R * K + C) * 2u; voffB[i] = (unsigned)(Rb * K + C) * 2u; }
    const size_t kstep = (size_t)(BK * 2);
    const size_t hstep = (size_t)HALF * K * 2;
    const unsigned ldsw = (unsigned)wid * 1024u;
    const int aoff = lds_byte(wr * 64 + fr, fq * 8), boff = lds_byte(wc * 32 + fr, fq * 8);
#define PG8_SA(b, h) (((b) * 2 + (h)) * HTB)
#define PG8_SB(b, h) ((4 + (b) * 2 + (h)) * HTB)
#define PG8_STAGE(bufoff, gbase, voff) do { _Pragma("unroll") for (int _i = 0; _i < 2; ++_i) \
        __builtin_amdgcn_global_load_lds((const unsigned*)((const char*)(gbase) + (voff)[_i]), (LAS unsigned*)(lds + (bufoff) + ldsw + _i * 8192), 16, 0, 0); } while (0)
#define PG8_LDA(dst, b, h) do { _Pragma("unroll") for (int m = 0; m < 4; ++m) _Pragma("unroll") for (int k = 0; k < 2; ++k) dst[m][k] = *(const LAS bf16x8*)(lds + PG8_SA(b, h) + aoff + m * 2048 + k * 1024); } while (0)
#define PG8_LDB(dst, b, h) do { _Pragma("unroll") for (int n = 0; n < 2; ++n) _Pragma("unroll") for (int k = 0; k < 2; ++k) dst[n][k] = *(const LAS bf16x8*)(lds + PG8_SB(b, h) + boff + n * 2048 + k * 1024); } while (0)
#define PG8_MMA(ai, bj, At, Bt) do { __builtin_amdgcn_s_setprio(1); _Pragma("unroll") for (int m = 0; m < 4; ++m) _Pragma("unroll") for (int n = 0; n < 2; ++n) _Pragma("unroll") for (int k = 0; k < 2; ++k) \
        acc[ai][bj][m][n] = __builtin_amdgcn_mfma_f32_16x16x32_bf16(Bt[n][k], At[m][k], acc[ai][bj][m][n], 0, 0, 0); __builtin_amdgcn_s_setprio(0); } while (0)
#define PG8_WAIT_V(n) asm volatile("s_waitcnt vmcnt(" #n ")" ::: "memory")
#define PG8_WAIT_L(n) asm volatile("s_waitcnt lgkmcnt(" #n ")" ::: "memory")
#define PG8_BAR __builtin_amdgcn_s_barrier()
#define PG8_SCHED __builtin_amdgcn_sched_barrier(0)
    Unit cur, nxt; int ui = 0;
    if (!S.next(0, cur)) return;
    f32x4 acc[2][2][4][2];
#pragma unroll
    for (int a = 0; a < 2; ++a)
#pragma unroll
        for (int b = 0; b < 2; ++b)
#pragma unroll
            for (int m = 0; m < 4; ++m)
#pragma unroll
                for (int n = 0; n < 2; ++n) acc[a][b][m][n] = (f32x4){0.f, 0.f, 0.f, 0.f};
    bf16x8 At[4][2], B0[2][2], B1[2][2];
    const char* cA = cur.a; const char* cB = cur.b;
    PG8_STAGE(PG8_SB(0, 0), cB, voffB); PG8_STAGE(PG8_SB(0, 1), cB + hstep, voffB); PG8_STAGE(PG8_SA(0, 0), cA, voffA); PG8_STAGE(PG8_SA(0, 1), cA + hstep, voffA);
    if (wr == 1) PG8_BAR;
    PG8_WAIT_V(2); PG8_BAR;
    PG8_STAGE(PG8_SB(1, 0), cB + kstep, voffB); PG8_STAGE(PG8_SA(1, 0), cA + kstep, voffA); PG8_STAGE(PG8_SB(1, 1), cB + hstep + kstep, voffB);
    PG8_WAIT_V(6); PG8_BAR;
    for (;;) {
        const bool has_next = S.next(ui + 1, nxt);
        const char* nA = has_next ? nxt.a : cA; const char* nB = has_next ? nxt.b : cB;
        for (int t = 0; t < nt; t += 2) {
            const bool last = (t == nt - 2);
            const char* a1 = cA + (size_t)(t + 1) * kstep;
            const char* a2 = last ? nA : cA + (size_t)(t + 2) * kstep; const char* b2 = last ? nB : cB + (size_t)(t + 2) * kstep;
            const char* a3 = a2 + kstep; const char* b3 = b2 + kstep;
            PG8_LDB(B0, 0, 0); PG8_LDB(B1, 0, 1); PG8_SCHED; PG8_LDA(At, 0, 0); PG8_STAGE(PG8_SA(1, 1), a1 + hstep, voffA);
            PG8_WAIT_V(8); PG8_WAIT_L(0); PG8_BAR; PG8_MMA(0, 0, At, B0); PG8_MMA(0, 1, At, B1); PG8_BAR; PG8_SCHED;
            PG8_LDA(At, 0, 1); PG8_STAGE(PG8_SB(0, 0), b2, voffB); PG8_STAGE(PG8_SB(0, 1), b2 + hstep, voffB); PG8_STAGE(PG8_SA(0, 0), a2, voffA);
            PG8_WAIT_V(8); PG8_WAIT_L(0); PG8_BAR; PG8_MMA(1, 0, At, B0); PG8_MMA(1, 1, At, B1); PG8_BAR; PG8_SCHED;
            PG8_LDB(B0, 1, 0); PG8_LDB(B1, 1, 1); PG8_SCHED; PG8_LDA(At, 1, 0); PG8_STAGE(PG8_SA(0, 1), a2 + hstep, voffA);
            PG8_WAIT_V(8); PG8_WAIT_L(0); PG8_BAR; PG8_MMA(0, 0, At, B0); PG8_MMA(0, 1, At, B1); PG8_BAR; PG8_SCHED;
            PG8_LDA(At, 1, 1); PG8_STAGE(PG8_SB(1, 0), b3, voffB); PG8_STAGE(PG8_SB(1, 1), b3 + hstep, voffB); PG8_STAGE(PG8_SA(1, 0), a3, voffA);
            PG8_WAIT_V(8); PG8_WAIT_L(0); PG8_BAR; PG8_MMA(1, 0, At, B0); PG8_MMA(1, 1, At, B1); PG8_BAR; PG8_SCHED;
        }
        if (wr == 0) PG8_BAR;
        epilogue<PH>(acc, cur, wr, wc, fr, fq, E);
        if (!has_next) break;
#pragma unroll
        for (int a = 0; a < 2; ++a)
#pragma unroll
            for (int b = 0; b < 2; ++b)
#pragma unroll
                for (int m = 0; m < 4; ++m)
#pragma unroll
                    for (int n = 0; n < 2; ++n) acc[a][b][m][n] = (f32x4){0.f, 0.f, 0.f, 0.f};
        cur = nxt; cA = nA; cB = nB; ++ui;
        if (wr == 1) PG8_BAR;
    }
    PG8_WAIT_V(0);
    PG8_BAR;
#undef PG8_SA
#undef PG8_SB
#undef PG8_STAGE
#undef PG8_LDA
#undef PG8_LDB
#undef PG8_MMA
#undef PG8_WAIT_V
#undef PG8_WAIT_L
#undef PG8_BAR
#undef PG8_SCHED
}

__device__ __forceinline__ int wt_dst_row(int c) {
    if (c < 1024) {
        const int base = c & ~511, local = c & 511, head = local >> 6, d = local & 63;
        const int pnl = head >> 2, wc = head & 3, bj = d >> 5, n = (d >> 4) & 1, f = d & 15, fq = f >> 2, j = f & 3;
        return base + pnl * 256 + 128 * bj + 32 * wc + 8 * fq + 4 * n + j;
    } else if (c < 2048) {
        return c;
    } else {
        const int type = (c - 2048) >> 9, ch = (c - 2048) & 511, ct = ch >> 6, chl = ch & 63;
        const int wc = chl >> 4, fq = (chl >> 2) & 3, j = chl & 3, bj = type >> 1, n = type & 1;
        return 2048 + ct * 256 + 128 * bj + 32 * wc + 8 * fq + 4 * n + j;
    }
}
template <bool PERMUTE>
__device__ __forceinline__ void p0_transpose_item(const float* W, int N, bf16_t* WT, LAS float* scr, int item, int lane) {
    const int nblk = N / 32, kb = item / nblk, nb = item % nblk, k0 = 64 * kb, n0 = 32 * nb;
    const int loff = (lane >> 5) * N + (lane & 31);
#pragma unroll
    for (int hh = 0; hh < 2; ++hh) {
        float tv[16];
#pragma unroll
        for (int i = 0; i < 16; ++i) { const float* wu = W + (size_t)(k0 + 2 * (16 * hh + i)) * N + n0; tv[i] = __builtin_nontemporal_load(wu + loff); }
#pragma unroll
        for (int i = 0; i < 16; ++i) scr[(2 * (16 * hh + i) + (lane >> 5)) * 33 + (lane & 31)] = tv[i];
    }
    asm volatile("s_waitcnt lgkmcnt(0)" ::: "memory");
    const int c = lane & 7;
#pragma unroll
    for (int j = 0; j < 4; ++j) { const int n = (lane >> 3) + 8 * j; const LAS float* s = scr + (8 * c) * 33 + n;
        u32x4 o; o.x = cvtpk(s[0 * 33], s[1 * 33]); o.y = cvtpk(s[2 * 33], s[3 * 33]); o.z = cvtpk(s[4 * 33], s[5 * 33]); o.w = cvtpk(s[6 * 33], s[7 * 33]);
        const int drow = PERMUTE ? wt_dst_row(n0 + n) : (n0 + n);
        *(u32x4*)(WT + (size_t)drow * KDIM + k0 + 8 * c) = o; }
    asm volatile("s_waitcnt lgkmcnt(0)" ::: "memory");
}

__device__ __forceinline__ void phase0(const Params& p, LAS unsigned char* lds) {
    const int tid = threadIdx.x, lane = tid & 63, wave = __builtin_amdgcn_readfirstlane(tid >> 6);
    const int G = gridDim.x;
    LAS float* scr = (LAS float*)(lds + wave * 8704);
    bf16_t* WT = (bf16_t*)(p.ws + WS_WT); bf16_t* WO = (bf16_t*)(p.ws + WS_WO);
    float* ADAP = (float*)(p.ws + WS_ADAP);
    const int gw = wave * G + blockIdx.x, NGW = G * 8;
    constexpr int N_ADA = 1536, N_TIN = (KDIM / 64) * (DIN / 32), N_TOUT = (KDIM / 64) * (DM / 32);
    for (int it = gw; it < N_ADA + N_TIN + N_TOUT; it += NGW) {
        if (it < N_ADA) {
            const int cgp = it % 96, kc = it / 96, col = cgp * 32 + (lane & 31), kh = (lane >> 5) * 32, k0 = kc * 64;
#pragma unroll
            for (int r = 0; r < 9; ++r) { const float v = (r < 8) ? p.c[r * 1024 + k0 + lane] : p.c_ctx[k0 + lane]; scr[r * 64 + lane] = v * (1.0f / (1.0f + __expf(-v))); }
            asm volatile("s_waitcnt lgkmcnt(0)" ::: "memory");
            float a[9];
#pragma unroll
            for (int r = 0; r < 9; ++r) a[r] = 0.f;
            const float* wp = p.w_ada + (size_t)(k0 + kh) * NADA + col;
#pragma unroll 16
            for (int kk = 0; kk < 32; ++kk) {
                const float w = __builtin_nontemporal_load(wp + (size_t)kk * NADA);
#pragma unroll
                for (int r = 0; r < 9; ++r) a[r] += scr[r * 64 + kh + kk] * w;
            }
#pragma unroll
            for (int r = 0; r < 9; ++r) { a[r] += __shfl_xor(a[r], 32); if (lane < 32) ADAP[(size_t)(kc * 9 + r) * NADA + col] = a[r]; }
            asm volatile("s_waitcnt lgkmcnt(0)" ::: "memory");
        } else if (it < N_ADA + N_TIN) {
            p0_transpose_item<true>(p.w_in, DIN, WT, scr, it - N_ADA, lane);
        } else {
            p0_transpose_item<false>(p.w_out, DM, WO, scr, it - N_ADA - N_TIN, lane);
        }
    }
    if (blockIdx.x == 0) {
        float* rope = (float*)(p.ws + WS_ROPE);
        if (tid < 16) {
            double inv = 1.0; for (int i = 0; i < tid; ++i) inv *= 0.5623413251903491;
            const double a = (double)(float)inv;
            double s = 0.0, c = 0.0, term = 1.0;
            for (int n = 0; n < 24; ++n) { if ((n & 1) == 0) c += ((n & 2) ? -term : term); else s += ((n & 2) ? -term : term); term *= a / (double)(n + 1); }
            double cp = 1.0, sp = 0.0;
            for (int pos = 0; pos < 64; ++pos) { rope[pos * 16 + tid] = (float)cp; rope[1024 + pos * 16 + tid] = (float)sp; const double cn = cp * c - sp * s, sn = sp * c + cp * s; cp = cn; sp = sn; }
        }
        if (wave == 1) {
            float mq = fabsf(p.q_norm_g[lane]), mk = fabsf(p.k_norm_g[lane]), mr = 0.f;
            for (int i = lane; i < NH * 15 * 31; i += 64) mr = fmaxf(mr, fabsf(p.rpb[i]));
#pragma unroll
            for (int o = 1; o < 64; o <<= 1) { mq = fmaxf(mq, __shfl_xor(mq, o)); mk = fmaxf(mk, __shfl_xor(mk, o)); mr = fmaxf(mr, __shfl_xor(mr, o)); }
            if (lane == 0) *(float*)(p.ws + WS_BND) = (8.0f * mq * mk + mr) * LOG2E;
        }
    }
}

template <int NR>
__device__ __forceinline__ void p1_rows(const float* src0, bf16_t* dst0, const LAS float* mult, const LAS float* shf, int lane) {
    f32x4 v[NR][4];
#pragma unroll
    for (int r = 0; r < NR; ++r)
#pragma unroll
        for (int j = 0; j < 4; ++j) v[r][j] = __builtin_nontemporal_load((const f32x4*)(src0 + (size_t)r * DM) + lane + 64 * j);
#pragma unroll
    for (int r = 0; r < NR; ++r) {
        float s = 0.f;
#pragma unroll
        for (int j = 0; j < 4; ++j) { const f32x4 t = v[r][j] * v[r][j]; s += (t[0] + t[1]) + (t[2] + t[3]); }
        const float rinv = __builtin_amdgcn_rsqf(wave_sum(s) * (1.0f / DM) + RMS_EPS);
        u32x2* o8 = (u32x2*)(dst0 + (size_t)r * DM) + lane;
#pragma unroll
        for (int j = 0; j < 4; ++j) {
            const f32x4 mu = *(const LAS f32x4*)(mult + 4 * lane + 256 * j), sv = *(const LAS f32x4*)(shf + 4 * lane + 256 * j);
            const f32x4 h = v[r][j] * rinv * mu + sv;
            u32x2 w; w.x = cvtpk(h[0], h[1]); w.y = cvtpk(h[2], h[3]); o8[64 * j] = w;
        }
    }
}
__device__ __forceinline__ void phase1(const Params& p, LAS unsigned char* lds) {
    const int tid = threadIdx.x, lane = tid & 63, wave = __builtin_amdgcn_readfirstlane(tid >> 6);
    LAS float* multL = (LAS float*)lds; LAS float* shfL = (LAS float*)(lds + 4096); LAS float* multC = (LAS float*)(lds + 8192); LAS float* shfC = (LAS float*)(lds + 12288);
    const float* ADAP = (const float*)(p.ws + WS_ADAP);
    bf16_t* XN = (bf16_t*)(p.ws + WS_XN); float* GATE = (float*)(p.ws + WS_GATE);
    for (int slot = blockIdx.x; slot < 256; slot += gridDim.x) {
        const int ci = slot >> 5;
        __syncthreads();
        for (int k = tid; k < 1024; k += NTHREADS) {
            float sh = p.b_ada[k], scl = p.b_ada[1024 + k], shc = sh, sclc = scl;
#pragma unroll
            for (int kc = 0; kc < 16; ++kc) {
                sh += ADAP[(size_t)(kc * 9 + ci) * NADA + k]; scl += ADAP[(size_t)(kc * 9 + ci) * NADA + 1024 + k];
                shc += ADAP[(size_t)(kc * 9 + 8) * NADA + k]; sclc += ADAP[(size_t)(kc * 9 + 8) * NADA + 1024 + k];
            }
            const float g = p.norm_g[k];
            multL[k] = g * (1.0f + scl); shfL[k] = sh; multC[k] = g * (1.0f + sclc); shfC[k] = shc;
            if ((slot & 31) == 0) {
                float gt = p.b_ada[2048 + k];
#pragma unroll
                for (int kc = 0; kc < 16; ++kc) gt += ADAP[(size_t)(kc * 9 + ci) * NADA + 2048 + k];
                GATE[ci * DM + k] = gt;
            }
        }
        __syncthreads();
        const size_t r0 = (size_t)slot * 64 + wave * 8;
        p1_rows<4>(p.x + r0 * DM, XN + r0 * DM, multL, shfL, lane);
        p1_rows<4>(p.x + (r0 + 4) * DM, XN + (r0 + 4) * DM, multL, shfL, lane);
        { const size_t rc = (size_t)slot * 8 + wave; p1_rows<1>(p.ctx + rc * DM, XN + ((size_t)MLAT + rc) * DM, multC, shfC, lane); }
    }
}

__device__ __forceinline__ int swz_k(int key) { return ((key >> 1) & 1) * 2 + ((key >> 3) & 1) * 4; }
__device__ __forceinline__ int swz_v(int d) { return ((d >> 1) & 1) * 2 + ((d >> 2) & 1) * 4; }

__device__ __forceinline__ void glds16(const void* gsrc, unsigned lds_dst) { unsigned keep;
    asm volatile("s_mov_b32 %0, m0\n\ts_mov_b32 m0, %2\n\ts_nop 0\n\tglobal_load_lds_dwordx4 %1, off\n\ts_mov_b32 m0, %0" : "=&s"(keep) : "v"(gsrc), "s"(lds_dst) : "memory"); }

__device__ __forceinline__ void gload16_async(bf16x8& dst, const void* ptr) { asm volatile("global_load_dwordx4 %0, %1, off" : "+v"(dst) : "v"(ptr) : "memory"); }
__device__ __forceinline__ void gload8_async(u32x2& dst, const void* ptr) { asm volatile("global_load_dwordx2 %0, %1, off" : "+v"(dst) : "v"(ptr) : "memory"); }

template <bool LAT>
__device__ __forceinline__ void att_blk(const LAS unsigned char* kc, unsigned ko0, unsigned ko1, const LAS unsigned char* vc, unsigned vo,
                                        const bf16x8 q0, const bf16x8 q1, const LAS float* tb, float B2, unsigned vmask, f32x4 (&o)[4], float& lsum) {
    const bf16x8 k00 = *(const LAS bf16x8*)(kc + ko0), k01 = *(const LAS bf16x8*)(kc + ko1), k10 = *(const LAS bf16x8*)(kc + ko0 + 512), k11 = *(const LAS bf16x8*)(kc + ko1 + 512);
    bf16x8 vf[4];
#pragma unroll
    for (int db = 0; db < 4; ++db) vf[db] = *(const LAS bf16x8*)(vc + vo + db * 2048);
    const f32x4 zero4 = {0.f, 0.f, 0.f, 0.f};
    f32x4 s0 = __builtin_amdgcn_mfma_f32_16x16x32_bf16(k00, q0, zero4, 0, 0, 0); s0 = __builtin_amdgcn_mfma_f32_16x16x32_bf16(k01, q1, s0, 0, 0, 0);
    f32x4 s1 = __builtin_amdgcn_mfma_f32_16x16x32_bf16(k10, q0, zero4, 0, 0, 0); s1 = __builtin_amdgcn_mfma_f32_16x16x32_bf16(k11, q1, s1, 0, 0, 0);
    float pj[8];
#pragma unroll
    for (int j = 0; j < 8; ++j) {
        const float sv = (j < 4 ? s0[j] : s1[j - 4]);
        if (LAT) { const float e = __builtin_amdgcn_exp2f(sv + tb[j]); pj[j] = ((vmask >> j) & 1u) ? e : 0.f; }
        else pj[j] = __builtin_amdgcn_exp2f(sv - B2);
        lsum += pj[j];
    }
    u32x4 pw; pw.x = cvtpk(pj[0], pj[1]); pw.y = cvtpk(pj[2], pj[3]); pw.z = cvtpk(pj[4], pj[5]); pw.w = cvtpk(pj[6], pj[7]);
    const bf16x8 pb = __builtin_bit_cast(bf16x8, pw);
#pragma unroll
    for (int db = 0; db < 4; ++db) o[db] = __builtin_amdgcn_mfma_f32_16x16x32_bf16(vf[db], pb, o[db], 0, 0, 0);
}

struct QcConst { int qcol, dcb; unsigned vmask, ak0, ak1, av; };
__device__ __forceinline__ QcConst make_qc(int qc, int q16, int quad) {
    QcConst c;
    c.qcol = qc * 16 + q16;
    const int cs = (qc == 0) ? 0 : (qc == 1) ? 8 : (qc == 2) ? 24 : 32;
    const int lo = min(max(c.qcol - 8, 0), 48);
    const int kcol0 = cs + 8 * quad;
    c.dcb = kcol0 - c.qcol + 15 + 16;
    c.vmask = 0;
#pragma unroll
    for (int j = 0; j < 8; ++j) { const int kc = kcol0 + j; if (kc >= lo && kc < lo + 16) c.vmask |= (1u << j); }
    const int keyl = cs + 8 * (q16 >> 2) + (q16 & 3);
    c.ak0 = keyl * 128 + ((quad ^ swz_k(keyl)) * 16); c.ak1 = keyl * 128 + (((4 + quad) ^ swz_k(keyl)) * 16);
    c.av = q16 * 128 + ((((cs >> 3) + quad) ^ swz_v(q16)) * 16);
    return c;
}
constexpr int A_CH = 15, A_LAT = 11, A_NS = 6, A_D = 5, A_RING = 32768, A_SLOT = 16384;
template <int COMPUTE>
__device__ __forceinline__ void phase3(const Params& p, LAS unsigned char* lds) {
    const int tid = threadIdx.x, lane = tid & 63, wave = __builtin_amdgcn_readfirstlane(tid >> 6);
    LAS float* btab = (LAS float*)lds;
    const float B2 = *(const float*)(p.ws + WS_BND);
    {
        float rv[15];
#pragma unroll
        for (int k = 0; k < 15; ++k) { const int idx = tid + k * NTHREADS, c = idx & 63, hd = idx >> 6; const int dc = min(max(c - 16, 0), 30); rv[k] = p.rpb[hd * 31 + dc]; }
#pragma unroll
        for (int k = 0; k < 15; ++k) btab[tid + k * NTHREADS] = rv[k] * LOG2E - B2;
    }
    __syncthreads();
    const int G = gridDim.x, x = blockIdx.x & 7, lb = blockIdx.x >> 3, nb = G >> 3;
    const bf16_t* QP = (const bf16_t*)(p.ws + WS_QP); const bf16_t* QR = (const bf16_t*)(p.ws + WS_QR);
    const bf16_t* KR = (const bf16_t*)(p.ws + WS_KR); const bf16_t* KC = (const bf16_t*)(p.ws + WS_KC);
    const bf16_t* VT = (const bf16_t*)(p.ws + WS_VT); const bf16_t* ZA = (const bf16_t*)(p.ws + WS_ZA);
    bf16_t* MIXo = (bf16_t*)(p.ws + WS_MIX);
    const unsigned lds0 = (unsigned)(size_t)lds;
    const int n_items = lb < 64 ? (64 - lb + nb - 1) / nb : 0;
    const int total = n_items * A_CH;
    const int irow = wave >> 1, qcp = wave & 1;
    const int q16 = lane & 15, quad = lane >> 4;
    const QcConst cA = make_qc(2 * qcp, q16, quad), cB = make_qc(2 * qcp + 1, q16, quad);
    const int keyc = 8 * (q16 >> 2) + (q16 & 3);
    const unsigned ck0 = keyc * 128 + ((quad ^ swz_k(keyc)) * 16), ck1 = keyc * 128 + (((4 + quad) ^ swz_k(keyc)) * 16);
    const unsigned cv0 = q16 * 128 + ((quad ^ swz_v(q16)) * 16), cv1 = q16 * 128 + (((4 + quad) ^ swz_v(q16)) * 16);
    const int drow = wave * 8 + (lane >> 3), dsl = lane & 7;
    const size_t ksrc_off = (size_t)drow * HD + ((dsl ^ swz_k(drow)) * 8);
    const size_t vsrc_off = (size_t)drow * MTOT + ((dsl ^ swz_v(drow)) * 8);
#define A_ISSUE(seq_) do { const int _n = (seq_) / A_CH, _cj = (seq_) - _n * A_CH, _li = lb + _n * nb, _bh = 8 * x + (_li >> 3), _i0 = 4 * (_li & 7); \
        const int _b = _bh >> 3, _h = _bh & 7, _R0 = min(max(_i0 - 4, 0), 24); const int _slot = (seq_) % A_NS; \
        const bf16_t* _ks; const bf16_t* _vs; \
        if (_cj < A_LAT) { const int _r = min(_R0 + _cj, 31); _ks = KR + ((size_t)_bh * SEQ + _r * 64) * HD + ksrc_off; _vs = VT + (size_t)(_h * HD) * MTOT + _b * SEQ + _r * 64 + vsrc_off; } \
        else { const int _c = _cj - A_LAT; _ks = KC + ((size_t)_bh * CTXL + _c * 64) * HD + ksrc_off; _vs = VT + (size_t)(_h * HD) * MTOT + MLAT + _b * CTXL + _c * 64 + vsrc_off; } \
        glds16(_ks, (unsigned)__builtin_amdgcn_readfirstlane((int)(lds0 + A_RING + _slot * A_SLOT + wave * 1024))); \
        glds16(_vs, (unsigned)__builtin_amdgcn_readfirstlane((int)(lds0 + A_RING + _slot * A_SLOT + 8192 + wave * 1024))); } while (0)
#define A_LOADQ(n_) do { const int _li = lb + (n_) * nb, _bh = 8 * x + (_li >> 3), _i = 4 * (_li & 7) + irow; \
        const size_t _qa = ((size_t)_bh * SEQ + _i * 64 + cA.qcol) * HD + quad * 8, _qb = ((size_t)_bh * SEQ + _i * 64 + cB.qcol) * HD + quad * 8; \
        qrA0 = *(const bf16x8*)(QR + _qa); qrA1 = *(const bf16x8*)(QR + _qa + 32); qpA0 = *(const bf16x8*)(QP + _qa); qpA1 = *(const bf16x8*)(QP + _qa + 32); \
        qrB0 = *(const bf16x8*)(QR + _qb); qrB1 = *(const bf16x8*)(QR + _qb + 32); qpB0 = *(const bf16x8*)(QP + _qb); qpB1 = *(const bf16x8*)(QP + _qb + 32); \
        const size_t _tz = (size_t)(_bh >> 3) * SEQ + _i * 64; const int _hz = (_bh & 7) * HD + 4 * quad; \
        _Pragma("unroll") for (int db = 0; db < 4; ++db) { zA[db] = *(const u32x2*)(ZA + (_tz + cA.qcol) * 512 + _hz + 16 * db); zB[db] = *(const u32x2*)(ZA + (_tz + cB.qcol) * 512 + _hz + 16 * db); } } while (0)
    bf16x8 qrA0, qrA1, qpA0, qpA1, qrB0, qrB1, qpB0, qpB1; u32x2 zA[4], zB[4];
#pragma unroll
    for (int db = 0; db < 4; ++db) { zA[db] = (u32x2){0u, 0u}; zB[db] = (u32x2){0u, 0u}; }
    if (n_items > 0) A_LOADQ(0);
    for (int s = 0; s < A_D && s < total; ++s) A_ISSUE(s);
    f32x4 oA[4], oB[4]; float lsA = 0.f, lsB = 0.f;
#pragma unroll
    for (int db = 0; db < 4; ++db) { oA[db] = (f32x4){0.f, 0.f, 0.f, 0.f}; oB[db] = (f32x4){0.f, 0.f, 0.f, 0.f}; }
    int n = 0, cj = 0;
    for (int seq = 0; seq < total; ++seq) {
        const int rem = total - 1 - seq;
        if (rem >= 4) asm volatile("s_waitcnt vmcnt(8)" ::: "memory");
        else if (rem == 3) asm volatile("s_waitcnt vmcnt(6)" ::: "memory");
        else if (rem == 2) asm volatile("s_waitcnt vmcnt(4)" ::: "memory");
        else if (rem == 1) asm volatile("s_waitcnt vmcnt(2)" ::: "memory");
        else asm volatile("s_waitcnt vmcnt(0)" ::: "memory");
        __builtin_amdgcn_s_barrier();
        asm volatile("" ::: "memory");
        if (seq + A_D < total) A_ISSUE(seq + A_D);
        const int li = lb + n * nb, bh = 8 * x + (li >> 3), i0 = 4 * (li & 7), i = i0 + irow, b = bh >> 3, h = bh & 7;
        const LAS unsigned char* kc = lds + A_RING + (seq % A_NS) * A_SLOT; const LAS unsigned char* vc = kc + 8192;
        if (cj < A_LAT) {
            const int R0 = min(max(i0 - 4, 0), 24), rowu = R0 + cj, rsw = min(max(i - 4, 0), 24);
            if ((COMPUTE == 1 || COMPUTE == 2) && rowu >= rsw && rowu < rsw + 8) {
                const int dr = rowu - i + 7;
                const LAS float* tb = btab + (h * 15 + dr) * 64;
                att_blk<true>(kc, cA.ak0, cA.ak1, vc, cA.av, qrA0, qrA1, tb + cA.dcb, B2, cA.vmask, oA, lsA);
                att_blk<true>(kc, cB.ak0, cB.ak1, vc, cB.av, qrB0, qrB1, tb + cB.dcb, B2, cB.vmask, oB, lsB);
            }
        } else {
            if (COMPUTE == 1 || COMPUTE == 3) {
            att_blk<false>(kc, ck0, ck1, vc, cv0, qpA0, qpA1, nullptr, B2, 0u, oA, lsA);
            att_blk<false>(kc, ck0, ck1, vc, cv0, qpB0, qpB1, nullptr, B2, 0u, oB, lsB);
            att_blk<false>(kc + 4096, ck0, ck1, vc, cv1, qpA0, qpA1, nullptr, B2, 0u, oA, lsA);
            att_blk<false>(kc + 4096, ck0, ck1, vc, cv1, qpB0, qpB1, nullptr, B2, 0u, oB, lsB);
            }
        }
        if (++cj == A_CH) {
          if (COMPUTE == 1 || (COMPUTE >= 2 && lsA == 1.2345e-30f)) {
            lsA += __shfl_xor(lsA, 16); lsA += __shfl_xor(lsA, 32); lsB += __shfl_xor(lsB, 16); lsB += __shfl_xor(lsB, 32);
            const float invA = 1.0f / lsA, invB = 1.0f / lsB;
            const size_t tok = (size_t)b * SEQ + i * 64;
#pragma unroll
            for (int db = 0; db < 4; ++db) {
                { const float z0 = __builtin_bit_cast(float, zA[db].x << 16), z1 = __builtin_bit_cast(float, zA[db].x & 0xffff0000u), z2 = __builtin_bit_cast(float, zA[db].y << 16), z3 = __builtin_bit_cast(float, zA[db].y & 0xffff0000u);
                  u32x2 w; w.x = cvtpk(oA[db][0] * invA * z0, oA[db][1] * invA * z1); w.y = cvtpk(oA[db][2] * invA * z2, oA[db][3] * invA * z3);
                  *(u32x2*)(MIXo + (tok + cA.qcol) * DM + h * HD + 16 * db + 4 * quad) = w; oA[db] = (f32x4){0.f, 0.f, 0.f, 0.f}; }
                { const float z0 = __builtin_bit_cast(float, zB[db].x << 16), z1 = __builtin_bit_cast(float, zB[db].x & 0xffff0000u), z2 = __builtin_bit_cast(float, zB[db].y << 16), z3 = __builtin_bit_cast(float, zB[db].y & 0xffff0000u);
                  u32x2 w; w.x = cvtpk(oB[db][0] * invB * z0, oB[db][1] * invB * z1); w.y = cvtpk(oB[db][2] * invB * z2, oB[db][3] * invB * z3);
                  *(u32x2*)(MIXo + (tok + cB.qcol) * DM + h * HD + 16 * db + 4 * quad) = w; oB[db] = (f32x4){0.f, 0.f, 0.f, 0.f}; }
            }
          }
            lsA = 0.f; lsB = 0.f; cj = 0; ++n;
            if (COMPUTE != 0 && n < n_items) A_LOADQ(n);
        }
    }
#undef A_ISSUE
#undef A_LOADQ
    __syncthreads();
}
__device__ __forceinline__ void phase3_conv(const Params& p) {
    const int tid = threadIdx.x, G = gridDim.x;
    const bf16_t* CG = (const bf16_t*)(p.ws + WS_CG); bf16_t* MIX = (bf16_t*)(p.ws + WS_MIX);
    const int g = tid & 127, sub = tid >> 7;
    const f32x4 w0 = *(const f32x4*)(p.conv_w + 4 * g), w1 = *(const f32x4*)(p.conv_w + 512 + 4 * g), w2 = *(const f32x4*)(p.conv_w + 1024 + 4 * g), cb = *(const f32x4*)(p.conv_b + 4 * g);
#define LO16(u) __builtin_bit_cast(float, (u) << 16)
#define HI16(u) __builtin_bit_cast(float, (u) & 0xffff0000u)
    for (int chunk = blockIdx.x; chunk < MLAT / 32; chunk += G) {
        const int tok0 = chunk * 32 + sub * 8, t0 = tok0 & (SEQ - 1);
        const bf16_t* src = CG + (size_t)tok0 * 1024 + g * 8;
        u32x4 cur[8]; u32x2 pv = {0u, 0u}, nv = {0u, 0u};
#pragma unroll
        for (int k = 0; k < 8; ++k) cur[k] = *(const u32x4*)(src + (size_t)k * 1024);
        if (t0 > 0) pv = *(const u32x2*)(src - 1024);
        if (t0 + 8 < SEQ) nv = *(const u32x2*)(src + 8 * 1024);
        f32x4 cprev = {LO16(pv.x), HI16(pv.x), LO16(pv.y), HI16(pv.y)};
        f32x4 cc = {LO16(cur[0].x), HI16(cur[0].x), LO16(cur[0].y), HI16(cur[0].y)};
#pragma unroll
        for (int k = 0; k < 8; ++k) {
            const u32x2 nx = (k < 7) ? (u32x2){cur[k < 7 ? k + 1 : 7].x, cur[k < 7 ? k + 1 : 7].y} : nv;
            const f32x4 cn = {LO16(nx.x), HI16(nx.x), LO16(nx.y), HI16(nx.y)};
            const f32x4 gz = {LO16(cur[k].z), HI16(cur[k].z), LO16(cur[k].w), HI16(cur[k].w)};
            const f32x4 y = gz * (cb + w0 * cprev + w1 * cc + w2 * cn);
            u32x2 w; w.x = cvtpk(y[0], y[1]); w.y = cvtpk(y[2], y[3]);
            *(u32x2*)(MIX + (size_t)(tok0 + k) * DM + 512 + 4 * g) = w;
            cprev = cc; cc = cn;
        }
    }
#undef LO16
#undef HI16
}

#define XB_TMO      128
#define XB_XCNT(j)  (256  + 64 * (j))
#define XB_XSUB(j)  (1280 + 64 * (j))
#define XB_XGEN(j)  (2304 + 64 * (j))
#define XB_TOP      3328
#define XB_TOPGEN   3392
#define XCD_BAR_WORDS 3456
#define XB_SPIN_CAP (1u << 18)
__device__ __forceinline__ unsigned xb_ld(unsigned* p)              { return __hip_atomic_load(p, __ATOMIC_RELAXED, __HIP_MEMORY_SCOPE_AGENT); }
__device__ __forceinline__ unsigned xb_add(unsigned* p, unsigned v) { return __hip_atomic_fetch_add(p, v, __ATOMIC_RELAXED, __HIP_MEMORY_SCOPE_AGENT); }
__device__ __forceinline__ unsigned xb_xcc_id() { return (unsigned)__builtin_amdgcn_s_getreg((3 << 11) | 20) & 0xFu; }
#define XB_SPIN(cond, bar) do { unsigned _sp = 0; while (cond) { __builtin_amdgcn_s_sleep(1); \
    if ((++_sp & 255u) == 0u) { if (xb_ld(&(bar)[XB_TMO])) break; if (_sp > XB_SPIN_CAP) { atomicAdd(&(bar)[XB_TMO], 1u); break; } } } } while (0)
struct XcdBarrier { unsigned* bar; unsigned x; volatile LAS unsigned* st; };
__device__ __forceinline__ XcdBarrier xcd_barrier_post(unsigned* bar, volatile LAS unsigned* st) {
    XcdBarrier b; b.bar = bar; b.x = xb_xcc_id(); b.st = st;
    if (threadIdx.x == 0) (void)xb_add(&bar[XB_XCNT(b.x)], 1u);
    return b;
}
__device__ __forceinline__ void xcd_barrier_complete(unsigned* bar, unsigned x, unsigned& nloc, unsigned& nx) {
    const unsigned G = gridDim.x * gridDim.y * gridDim.z;
    unsigned sum, cnt, mine, sp = 0u;
    for (;;) {
        sum = 0u; cnt = 0u; mine = 0u;
#pragma unroll
        for (unsigned j = 0; j < 16; ++j) { const unsigned c = xb_ld(&bar[XB_XCNT(j)]); sum += c; cnt += (c > 0u) ? 1u : 0u; mine = (j == x) ? c : mine; }
        if (sum == G) break;
        __builtin_amdgcn_s_sleep(1);
        if ((++sp & 255u) == 0u) { if (xb_ld(&bar[XB_TMO])) break; if (sp > XB_SPIN_CAP) { atomicAdd(&bar[XB_TMO], 1u); break; } }
    }
    nloc = mine > 0u ? mine : 1u; nx = cnt > 0u ? cnt : 1u;
}
__device__ __forceinline__ void xcd_barrier(const XcdBarrier& b) {
    asm volatile("s_waitcnt vmcnt(0)" ::: "memory");
    __syncthreads();
    if (threadIdx.x == 0) {
        unsigned* bar = b.bar;
        __builtin_amdgcn_s_waitcnt(0);
        unsigned nloc = b.st[0], nx = b.st[1];
        if (nloc == 0u) { xcd_barrier_complete(bar, b.x, nloc, nx); b.st[0] = nloc; b.st[1] = nx; }
        const unsigned old = xb_add(&bar[XB_XSUB(b.x)], 1u);
        const unsigned gen = old / nloc;
        if (old + 1u == (gen + 1u) * nloc) {
            __builtin_amdgcn_fence(__ATOMIC_RELEASE, "agent");
            asm volatile("s_waitcnt vmcnt(0)" ::: "memory");
            const unsigned og = xb_add(&bar[XB_TOP], 1u);
            const unsigned tg = og / nx;
            if (og + 1u == (tg + 1u) * nx) xb_add(&bar[XB_TOPGEN], 1u);
            else XB_SPIN(xb_ld(&bar[XB_TOPGEN]) == tg, bar);
            __builtin_amdgcn_fence(__ATOMIC_ACQUIRE, "agent");
            xb_add(&bar[XB_XGEN(b.x)], 1u);
            asm volatile("s_waitcnt vmcnt(0)" ::: "memory");
        } else {
            XB_SPIN(xb_ld(&bar[XB_XGEN(b.x)]) == gen, bar);
            __builtin_amdgcn_fence(__ATOMIC_ACQUIRE, "agent");
            asm volatile("s_waitcnt vmcnt(0)" ::: "memory");
        }
    }
    __syncthreads();
}

__global__ void __launch_bounds__(NTHREADS, 2) fwd_megakernel(Params p) {
    extern __shared__ __attribute__((aligned(16))) unsigned char lds_raw[];
    LAS unsigned char* lds = (LAS unsigned char*)lds_raw;
    cg::grid_group grid = cg::this_grid();
    if (threadIdx.x < 16) ((LAS unsigned*)(lds + LDS_MISC))[threadIdx.x] = 0u;
    __syncthreads();
    XcdBarrier xbar = xcd_barrier_post((unsigned*)(p.ws + WS_BAR), (volatile LAS unsigned*)(lds + LDS_MISC));
    if (p.ph_lo < 0) grid.sync();
#define GSYNC() xcd_barrier(xbar)
    const int lo = p.ph_lo, hi = p.ph_hi;
    const int x = blockIdx.x & 7, lb = blockIdx.x >> 3, nb = gridDim.x >> 3;
    EpiCtx E;
    E.QP = (bf16_t*)(p.ws + WS_QP); E.QR = (bf16_t*)(p.ws + WS_QR); E.KR = (bf16_t*)(p.ws + WS_KR); E.KC = (bf16_t*)(p.ws + WS_KC);
    E.VT = (bf16_t*)(p.ws + WS_VT); E.ZA = (bf16_t*)(p.ws + WS_ZA); E.CG = (bf16_t*)(p.ws + WS_CG);
    E.gq = p.q_norm_g; E.gk = p.k_norm_g; E.rope = (const float*)(p.ws + WS_ROPE);
    E.x = p.x; E.gate = (const float*)(p.ws + WS_GATE); E.out = p.out;
#define IN(k) (lo <= (k) && (k) < hi)
#define SEAM(k) do { if (IN(k) && IN((k) + 1)) GSYNC(); } while (0)
#define REP(k, ...) do { if (IN(k)) { __VA_ARGS__; if (PROBE_REP == (k)) { GSYNC(); __VA_ARGS__; } } } while (0)
    REP(0, phase0(p, lds));
    SEAM(0);
    REP(1, phase1(p, lds));
    SEAM(1);
    REP(2, { SchedP2 S{x, lb, nb, (const char*)(p.ws + WS_XN), (const char*)(p.ws + WS_WT)}; gemm_phase<2>(lds, S, E); });
    SEAM(2);
    REP(3, phase3<1>(p, lds));
    if (IN(3) && PROBE_REP == 32) { GSYNC(); phase3<0>(p, lds); }
    if (IN(3) && PROBE_REP == 33) { GSYNC(); phase3<2>(p, lds); }
    if (IN(3) && PROBE_REP == 34) { GSYNC(); phase3<3>(p, lds); }
    if (IN(3)) { phase3_conv(p); if (PROBE_REP == 31) { GSYNC(); phase3_conv(p); } }
    SEAM(3);
    REP(4, { SchedP4 S{x, lb, nb, (const char*)(p.ws + WS_MIX), (const char*)(p.ws + WS_WO)}; gemm_phase<4>(lds, S, E); });
#undef REP
    if (PROBE_REP == 99) { GSYNC(); GSYNC(); GSYNC(); GSYNC(); }
#undef IN
#undef SEAM
}

extern "C" void kernel_launch(void* const* d_in, const int* in_sizes, int n_in, void* d_out, int out_size, void* d_ws, size_t ws_size, hipStream_t stream) {
    static int grid = 0;
    if (grid == 0) {
        int dev = 0, cus = 0, per_cu = 0;
        hipGetDevice(&dev);
        hipDeviceGetAttribute(&cus, hipDeviceAttributeMultiprocessorCount, dev);
        if (hipFuncSetAttribute((const void*)fwd_megakernel, hipFuncAttributeMaxDynamicSharedMemorySize, LDS_BYTES) != hipSuccess) { fprintf(stderr, "hipFuncSetAttribute failed\n"); grid = -1; return; }
        hipOccupancyMaxActiveBlocksPerMultiprocessor(&per_cu, (const void*)fwd_megakernel, NTHREADS, LDS_BYTES);
        if (per_cu < 1) { fprintf(stderr, "occupancy query says %d blocks per CU\n", per_cu); grid = -1; return; }
        grid = cus;
        grid -= grid % 8;
        if (n_in != 14 || ws_size < WS_END || grid < 8) { fprintf(stderr, "unexpected problem geometry\n"); grid = -1; return; }
    }
    if (grid < 0) return;
    Params p{};
    p.x = (const float*)d_in[0]; p.c = (const float*)d_in[1]; p.ctx = (const float*)d_in[2]; p.c_ctx = (const float*)d_in[3];
    p.w_ada = (const float*)d_in[4]; p.b_ada = (const float*)d_in[5]; p.norm_g = (const float*)d_in[6]; p.w_in = (const float*)d_in[7];
    p.q_norm_g = (const float*)d_in[8]; p.k_norm_g = (const float*)d_in[9]; p.rpb = (const float*)d_in[10]; p.conv_w = (const float*)d_in[11];
    p.conv_b = (const float*)d_in[12]; p.w_out = (const float*)d_in[13];
    p.out = (float*)d_out; p.ws = (unsigned char*)d_ws;
    if (hipMemsetAsync((char*)d_ws + WS_BAR, 0, BAR_BYTES, stream) != hipSuccess) { fprintf(stderr, "memset of barrier words failed\n"); return; }
#if N_LAUNCH_MODE == 1
    p.ph_lo = 0; p.ph_hi = 5;
    void* args[] = {&p};
    hipError_t e = hipLaunchCooperativeKernel((const void*)fwd_megakernel, dim3(grid), dim3(NTHREADS), args, LDS_BYTES, stream);
    if (e != hipSuccess) fprintf(stderr, "cooperative launch failed: %s (grid %d)\n", hipGetErrorString(e), grid);
#else
    for (int ph = 0; ph < 5; ++ph) {
        p.ph_lo = ph; p.ph_hi = ph + 1;
        hipLaunchKernelGGL(fwd_megakernel, dim3(grid), dim3(NTHREADS), LDS_BYTES, stream, p);
    }
#endif
}
```
